# Optimizing an MI355X kernel written in HIP

```python
import math
import jax, jax.numpy as jnp
from jax import lax
import numpy as np

D_MODEL = 1024
BATCH = 8
SEQ = 2048
DEPTH = 4

N_MIXERS = 4
HEAD_DIM = 64
ROPE_THETA = 500000.0
ROT_DIM = HEAD_DIM // 4
NEG_INF = -1e30
RMS_EPS = 1e-6
Q_BLOCK = 128

DIL_PAIRS = ((128, 1), (512, 4), (2048, 16))
A_HEADS_PER_GROUP = 5
A_HEADS = A_HEADS_PER_GROUP * len(DIL_PAIRS)
BAND_BLOCK = 64

B_HEADS = 16
B_Q_RANK = 256
B_KV_RANK = 128
B_NOPE = 64
B_ROPE = 32
B_V = 64

C_HEADS = 16
GRID_W = 64
NA_ROWS = 8
NA_COLS = 16

D_HEADS = 8
D_HEAD = 64

MLP_HIDDEN = 4 * D_MODEL
PLE_DIM = 256

kernel_name = "hybrid_interleaved_bidir_encoder"


def rmsnorm(x, g):
    xf = x.astype(jnp.float32)
    y = xf * lax.rsqrt(jnp.mean(xf * xf, axis=-1, keepdims=True) + RMS_EPS)
    return (y * g.astype(jnp.float32)).astype(x.dtype)


def rope_tables(seq_len, rot_dim):
    inv = ROPE_THETA ** (-jnp.arange(0, rot_dim, 2, dtype=jnp.float32) / rot_dim)
    ang = jnp.arange(seq_len, dtype=jnp.float32)[:, None] * inv[None, :]
    return jnp.cos(ang), jnp.sin(ang)


def apply_rope(x, cos, sin):
    r = cos.shape[-1]
    c = cos.astype(x.dtype)
    s = sin.astype(x.dtype)
    x1, x2, rest = x[..., :r], x[..., r:2 * r], x[..., 2 * r:]
    return jnp.concatenate([x1 * c - x2 * s, x2 * c + x1 * s, rest], axis=-1)


def banded_attention(q, k, v, half):
    Z, L, dh = q.shape
    qb = math.gcd(L, BAND_BLOCK)
    nb = L // qb
    kw = qb + 2 * half
    kp = jnp.pad(k, ((0, 0), (half, half), (0, 0)))
    vp = jnp.pad(v, ((0, 0), (half, half), (0, 0)))
    idx = np.arange(nb)[:, None] * qb + np.arange(kw)[None, :]
    kb = kp[:, idx]
    vb = vp[:, idx]
    rel = np.arange(kw)[None, :] - half - np.arange(qb)[:, None]
    kpos = idx - half
    valid = (np.abs(rel) <= half)[None] & ((kpos >= 0) & (kpos < L))[:, None, :]
    s = jnp.einsum('znqd,znkd->znqk', q.reshape(Z, nb, qb, dh), kb).astype(jnp.float32) * (dh ** -0.5)
    s = jnp.where(valid, s, NEG_INF)
    m = jnp.max(s, axis=-1, keepdims=True)
    e = jnp.exp(s - m)
    l = jnp.sum(e, axis=-1, keepdims=True)
    o = jnp.einsum('znqk,znkd->znqd', (e / l).astype(v.dtype), vb)
    lse = (m + jnp.log(l))[..., 0]
    return o.reshape(Z, L, dh), lse.reshape(Z, L)


def dense_block_attention(q, k, v, scale):
    B, H, S, dq = q.shape
    nb = S // Q_BLOCK
    qb = q.reshape(B, H, nb, Q_BLOCK, dq).transpose(2, 0, 1, 3, 4)

    def one(qi):
        s = jnp.einsum('bhqd,bhkd->bhqk', qi, k).astype(jnp.float32) * scale
        pr = jax.nn.softmax(s, axis=-1)
        return jnp.einsum('bhqk,bhkd->bhqd', pr.astype(v.dtype), v)

    o = lax.map(one, qb)
    return o.transpose(1, 2, 0, 3, 4).reshape(B, H, S, v.shape[-1])


def diff_block_attention(q1, q2, k1, k2, v, lam, scale):
    B, H, S, d = q1.shape
    nb = S // Q_BLOCK
    blk = lambda t: t.reshape(B, H, nb, Q_BLOCK, d).transpose(2, 0, 1, 3, 4)

    def one(qs):
        a, b = qs
        p1 = jax.nn.softmax(jnp.einsum('bhqd,bhkd->bhqk', a, k1).astype(jnp.float32) * scale, axis=-1)
        p2 = jax.nn.softmax(jnp.einsum('bhqd,bhkd->bhqk', b, k2).astype(jnp.float32) * scale, axis=-1)
        return jnp.einsum('bhqk,bhkd->bhqd', (p1 - lam * p2).astype(v.dtype), v)

    o = lax.map(one, (blk(q1), blk(q2)))
    return o.transpose(1, 2, 0, 3, 4).reshape(B, H, S, v.shape[-1])


def neighborhood_attention(q, k, v, rpb):
    B, H, S, dh = q.shape
    rows = S // GRID_W
    kh = min(NA_ROWS, rows)
    cb = NA_COLS
    kcw = 2 * NA_COLS
    ncb = GRID_W // cb
    starts = np.clip(np.arange(ncb) * cb - NA_COLS // 2, 0, GRID_W - kcw)
    key_cols = starts[:, None] + np.arange(kcw)[None, :]
    q_cols = np.arange(GRID_W).reshape(ncb, cb)
    win0 = np.clip(q_cols - NA_COLS // 2, 0, GRID_W - NA_COLS)[..., None]
    kc = key_cols[:, None, :]
    col_mask = (kc >= win0) & (kc < win0 + NA_COLS)
    col_off = np.clip(kc - q_cols[..., None] + NA_COLS - 1, 0, 2 * NA_COLS - 2)
    rpb_cols = rpb[:, :, col_off]
    grid = lambda t: t.reshape(B, H, rows, GRID_W, dh).transpose(2, 0, 1, 3, 4)
    qg, kg, vg = grid(q), grid(k), grid(v)
    scale = dh ** -0.5

    def one_row(r):
        rs = jnp.clip(r - kh // 2, 0, rows - kh)
        q_r = lax.dynamic_index_in_dim(qg, r, 0, keepdims=False).reshape(B, H, ncb, cb, dh)
        k_r = lax.dynamic_slice_in_dim(kg, rs, kh, 0)[:, :, :, key_cols]
        v_r = lax.dynamic_slice_in_dim(vg, rs, kh, 0)[:, :, :, key_cols]
        s = jnp.einsum('bhnqd,rbhnkd->bhnqrk', q_r, k_r).astype(jnp.float32) * scale
        row_off = rs + jnp.arange(kh) - r + NA_ROWS - 1
        bias = rpb_cols[:, row_off].astype(jnp.float32).transpose(0, 2, 3, 1, 4)
        s = jnp.where(col_mask[:, :, None, :], s + bias[None], NEG_INF)
        pr = jax.nn.softmax(s.reshape(B, H, ncb, cb, kh * kcw), axis=-1).reshape(s.shape)
        o = jnp.einsum('bhnqrk,rbhnkd->bhnqd', pr.astype(v.dtype), v_r)
        return o.reshape(B, H, GRID_W, dh)

    o = lax.map(one_row, jnp.arange(rows))
    return o.transpose(1, 2, 0, 3, 4).reshape(B, H, S, dh)


def _by_stride(t, dil):
    B, G, S, dh = t.shape
    return t.reshape(B, G, S // dil, dil, dh).transpose(0, 1, 3, 2, 4).reshape(B * G * dil, S // dil, dh)


def dilated_window_mixer(h, w_qkv, w_o, cos, sin):
    B, S, _ = h.shape
    G = A_HEADS_PER_GROUP
    qkv = (h @ w_qkv).reshape(B, S, 3, A_HEADS, HEAD_DIM).transpose(2, 0, 3, 1, 4)
    q = apply_rope(qkv[0], cos, sin)
    k = apply_rope(qkv[1], cos, sin)
    v = qkv[2]
    outs, lses = [], []
    for g, (window, dil) in enumerate(DIL_PAIRS):
        sl = slice(g * G, (g + 1) * G)
        half = window // (2 * dil)
        o, lse = banded_attention(_by_stride(q[:, sl], dil), _by_stride(k[:, sl], dil),
                                  _by_stride(v[:, sl], dil), half)
        outs.append(o.reshape(B, G, dil, S // dil, HEAD_DIM).transpose(0, 1, 3, 2, 4).reshape(B, G, S, HEAD_DIM))
        lses.append(lse.reshape(B, G, dil, S // dil).transpose(0, 1, 3, 2).reshape(B, G, S))
    alpha = jax.nn.softmax(jnp.stack(lses, axis=0), axis=0)
    o = jnp.concatenate([outs[g] * alpha[g][..., None].astype(h.dtype) for g in range(len(DIL_PAIRS))], axis=1)
    return o.transpose(0, 2, 1, 3).reshape(B, S, A_HEADS * HEAD_DIM) @ w_o


def latent_attention_mixer(h, w_in, q_norm, w_uq, kv_norm, w_ukv, w_o, cos, sin):
    B, S, _ = h.shape
    z = h @ w_in
    c_q = z[..., :B_Q_RANK]
    c_kv = z[..., B_Q_RANK:B_Q_RANK + B_KV_RANK]
    k_rope = z[..., B_Q_RANK + B_KV_RANK:]
    q = (rmsnorm(c_q, q_norm) @ w_uq).reshape(B, S, B_HEADS, B_NOPE + B_ROPE).transpose(0, 2, 1, 3)
    kv = (rmsnorm(c_kv, kv_norm) @ w_ukv).reshape(B, S, B_HEADS, B_NOPE + B_V).transpose(0, 2, 1, 3)
    q = jnp.concatenate([q[..., :B_NOPE], apply_rope(q[..., B_NOPE:], cos, sin)], axis=-1)
    k_rope = jnp.broadcast_to(apply_rope(k_rope, cos, sin)[:, None], (B, B_HEADS, S, B_ROPE))
    k = jnp.concatenate([kv[..., :B_NOPE], k_rope], axis=-1)
    v = kv[..., B_NOPE:]
    o = dense_block_attention(q, k, v, (B_NOPE + B_ROPE) ** -0.5)
    return o.transpose(0, 2, 1, 3).reshape(B, S, B_HEADS * B_V) @ w_o


def neighborhood_mixer(h, w_qkv, rpb, w_o):
    B, S, _ = h.shape
    qkv = (h @ w_qkv).reshape(B, S, 3, C_HEADS, HEAD_DIM).transpose(2, 0, 3, 1, 4)
    o = neighborhood_attention(qkv[0], qkv[1], qkv[2], rpb)
    return o.transpose(0, 2, 1, 3).reshape(B, S, C_HEADS * HEAD_DIM) @ w_o


def differential_mixer(h, w_qkv, lq1, lk1, lq2, lk2, subln, w_o, cos, sin, lambda_init):
    B, S, _ = h.shape
    q, k, v = jnp.split(h @ w_qkv, 3, axis=-1)
    q = apply_rope(q.reshape(B, S, 2 * D_HEADS, D_HEAD).transpose(0, 2, 1, 3), cos, sin).reshape(B, D_HEADS, 2, S, D_HEAD)
    k = apply_rope(k.reshape(B, S, 2 * D_HEADS, D_HEAD).transpose(0, 2, 1, 3), cos, sin).reshape(B, D_HEADS, 2, S, D_HEAD)
    v = v.reshape(B, S, D_HEADS, 2 * D_HEAD).transpose(0, 2, 1, 3)
    f32 = jnp.float32
    lam = (jnp.exp(jnp.sum(lq1.astype(f32) * lk1.astype(f32)))
           - jnp.exp(jnp.sum(lq2.astype(f32) * lk2.astype(f32))) + lambda_init)
    o = diff_block_attention(q[:, :, 0], q[:, :, 1], k[:, :, 0], k[:, :, 1], v, lam, D_HEAD ** -0.5)
    o = rmsnorm(o, subln) * (1.0 - lambda_init)
    return o.transpose(0, 2, 1, 3).reshape(B, S, 2 * D_HEADS * D_HEAD) @ w_o


def sq_relu_mlp(h, w_up, w_down):
    return jnp.square(jax.nn.relu(h @ w_up)) @ w_down


def setup_inputs(seed: int = 0) -> dict:
    key = jax.random.key(seed)
    keys = iter(jax.random.split(key, 40))

    def nrm(shape, scale):
        return jax.random.normal(next(keys), shape, jnp.float32) * scale

    def gain(shape):
        return 1.0 + nrm(shape, 0.02)

    nA, nB, nC, nD = (len(range(m, DEPTH, N_MIXERS)) for m in range(N_MIXERS))
    D = D_MODEL
    return {
        "x": nrm((BATCH, SEQ, D), 1.0),
        "p": nrm((DEPTH, BATCH, SEQ, PLE_DIM), 1.0),
        "a_norm": gain((nA, D)),
        "a_w_qkv": nrm((nA, D, 3 * A_HEADS * HEAD_DIM), D ** -0.5),
        "a_w_o": nrm((nA, A_HEADS * HEAD_DIM, D), (A_HEADS * HEAD_DIM) ** -0.5),
        "b_norm": gain((nB, D)),
        "b_w_in": nrm((nB, D, B_Q_RANK + B_KV_RANK + B_ROPE), D ** -0.5),
        "b_q_norm": gain((nB, B_Q_RANK)),
        "b_w_uq": nrm((nB, B_Q_RANK, B_HEADS * (B_NOPE + B_ROPE)), B_Q_RANK ** -0.5),
        "b_kv_norm": gain((nB, B_KV_RANK)),
        "b_w_ukv": nrm((nB, B_KV_RANK, B_HEADS * (B_NOPE + B_V)), B_KV_RANK ** -0.5),
        "b_w_o": nrm((nB, B_HEADS * B_V, D), (B_HEADS * B_V) ** -0.5),
        "c_norm": gain((nC, D)),
        "c_w_qkv": nrm((nC, D, 3 * C_HEADS * HEAD_DIM), D ** -0.5),
        "c_rpb": nrm((nC, C_HEADS, 2 * NA_ROWS - 1, 2 * NA_COLS - 1), 0.02),
        "c_w_o": nrm((nC, C_HEADS * HEAD_DIM, D), (C_HEADS * HEAD_DIM) ** -0.5),
        "d_norm": gain((nD, D)),
        "d_w_qkv": nrm((nD, D, 3 * 2 * D_HEADS * D_HEAD), D ** -0.5),
        "d_lambda_q1": nrm((nD, D_HEAD), 0.1),
        "d_lambda_k1": nrm((nD, D_HEAD), 0.1),
        "d_lambda_q2": nrm((nD, D_HEAD), 0.1),
        "d_lambda_k2": nrm((nD, D_HEAD), 0.1),
        "d_subln": gain((nD, 2 * D_HEAD)),
        "d_w_o": nrm((nD, 2 * D_HEADS * D_HEAD, D), (2 * D_HEADS * D_HEAD) ** -0.5),
        "mlp_norm": gain((DEPTH, D)),
        "w_up": nrm((DEPTH, D, MLP_HIDDEN), D ** -0.5),
        "w_down": nrm((DEPTH, MLP_HIDDEN, D), MLP_HIDDEN ** -0.5),
        "ple_norm": gain((DEPTH, D)),
        "w_ple_gate": nrm((DEPTH, D, D), D ** -0.5),
        "w_ple_proj": nrm((DEPTH, PLE_DIM, D), PLE_DIM ** -0.5),
        "final_norm": gain((D,)),
    }


def reference(x, p, a_norm, a_w_qkv, a_w_o,
              b_norm, b_w_in, b_q_norm, b_w_uq, b_kv_norm, b_w_ukv, b_w_o,
              c_norm, c_w_qkv, c_rpb, c_w_o,
              d_norm, d_w_qkv, d_lambda_q1, d_lambda_k1, d_lambda_q2, d_lambda_k2, d_subln, d_w_o,
              mlp_norm, w_up, w_down, ple_norm, w_ple_gate, w_ple_proj, final_norm):
    S = x.shape[1]
    cos_p, sin_p = rope_tables(S, ROT_DIM)
    cos_l, sin_l = rope_tables(S, B_ROPE)
    for i in range(DEPTH):
        mix, j = i % N_MIXERS, i // N_MIXERS
        if mix == 0:
            x = x + dilated_window_mixer(rmsnorm(x, a_norm[j]), a_w_qkv[j], a_w_o[j], cos_p, sin_p)
        elif mix == 1:
            x = x + latent_attention_mixer(rmsnorm(x, b_norm[j]), b_w_in[j], b_q_norm[j], b_w_uq[j],
                                           b_kv_norm[j], b_w_ukv[j], b_w_o[j], cos_l, sin_l)
        elif mix == 2:
            x = x + neighborhood_mixer(rmsnorm(x, c_norm[j]), c_w_qkv[j], c_rpb[j], c_w_o[j])
        else:
            lambda_init = 0.8 - 0.6 * math.exp(-0.3 * i)
            x = x + differential_mixer(rmsnorm(x, d_norm[j]), d_w_qkv[j], d_lambda_q1[j], d_lambda_k1[j],
                                       d_lambda_q2[j], d_lambda_k2[j], d_subln[j], d_w_o[j],
                                       cos_p, sin_p, lambda_init)
        x = x + sq_relu_mlp(rmsnorm(x, mlp_norm[i]), w_up[i], w_down[i])
        gate = jax.nn.sigmoid(rmsnorm(x, ple_norm[i]) @ w_ple_gate[i])
        x = x + gate * (p[i] @ w_ple_proj[i])
    return rmsnorm(x, final_norm)
```

```cpp
#include <hip/hip_runtime.h>
#include <hip/hip_cooperative_groups.h>
#include <cstdio>
#include <cstdint>
namespace cg = cooperative_groups;

namespace pg8 {
#define PG8_LAS __attribute__((address_space(3)))
typedef unsigned short bf16_t;
typedef short bf16x8 __attribute__((ext_vector_type(8)));
typedef float f32x4 __attribute__((ext_vector_type(4)));
typedef unsigned u32x4 __attribute__((ext_vector_type(4)));
constexpr int BM = 256, BK = 64, HALF = 128, HTB = HALF * BK * 2  , STAGE_BYTES = 8 * HTB, NXCD = 8, WGM = 8;

__host__ __device__ __forceinline__ int lds_byte(int r, int c) { const int st = (r >> 4) * 2 + (c >> 5), rr = r & 15, cc = c & 31, ob = rr * 64 + cc * 2; return st * 1024 + (ob ^ (((ob >> 9) & 1) << 5)); }
__host__ __device__ __forceinline__ void stage_rc(int b, int& R, int& C) { const int st = b / 1024, sb = b % 1024, swz = sb ^ (((sb >> 9) & 1) << 5); R = (st >> 1) * 16 + swz / 64; C = (st & 1) * 32 + (swz % 64) / 2; }
__host__ __device__ __forceinline__ int perm32(int rho) { const int n = rho >> 4, i = rho & 15; return 8 * (i >> 2) + 4 * n + (i & 3); }

struct Unit { int pm, pn; };
struct Gemm { const bf16_t* A; const bf16_t* Bt; int M, N, K; };

struct StaticOrder {
    int nM, nN, nwg, G, c;
    __host__ __device__ void init(int M, int N, int G_, int c_) { nM = M / BM; nN = N / BM; nwg = nM * nN; G = G_; c = c_; }
    __host__ __device__ bool next(int i, Unit& u) const {
        const long L = (long)i * G + c; if (L >= nwg) return false;
        int wgid = (int)L; { const int q = nwg / NXCD, r = nwg % NXCD, xcd = wgid % NXCD, off = wgid / NXCD; wgid = (xcd < r ? xcd * (q + 1) : r * (q + 1) + (xcd - r) * q) + off; }
        const int nig = WGM * nN, gid = wgid / nig, fm = gid * WGM, gsz = (nM - fm) < WGM ? (nM - fm) : WGM;
        u.pm = fm + ((wgid % nig) % gsz); u.pn = (wgid % nig) / gsz; return true;
    }
    __device__ __forceinline__ void a_ready(const Unit&) const {}
    __device__ __forceinline__ void done(const Unit&) const {}
};

template <class Epi, class Sched, bool ALIGN_EPI = false, bool SP2 = false>
__device__ __forceinline__ void gemm_phase(PG8_LAS unsigned char* lds, const Gemm g, const Sched& S, const Epi& E, const int tid_in) {
    int tid_o = tid_in; asm volatile("" : "+v"(tid_o));
    const int tid = tid_o, wid = __builtin_amdgcn_readfirstlane(tid >> 6), lane = tid & 63, wr = wid >> 2, wc = wid & 3, fr = lane & 15, fq = lane >> 4;
    const int K = g.K, nt = K / BK;
    unsigned voffA[2], voffB[2];
#pragma unroll
    for (int i = 0; i < 2; ++i) { int R, C; stage_rc(tid * 16 + i * 8192, R, C); const int Rb = Epi::PERM ? ((R & ~31) + perm32(R & 31)) : R;
        voffA[i] = (unsigned)(R * K + C) * 2u; voffB[i] = (unsigned)(Rb * K + C) * 2u; }
    const size_t kstep = (size_t)(BK * 2);
    const size_t hstep = (size_t)HALF * K * 2;
    const size_t tstep = 2 * hstep;
    const unsigned ldsw = (unsigned)wid * 1024u;
    const int aoff = lds_byte(wr * 64 + fr, fq * 8), boff = lds_byte(wc * 32 + fr, fq * 8);
#define PG8_SA(b, h) (((b) * 2 + (h)) * HTB)
#define PG8_SB(b, h) ((4 + (b) * 2 + (h)) * HTB)
#define PG8_STAGE(bufoff, gbase, voff) do { _Pragma("unroll") for (int _i = 0; _i < 2; ++_i) \
        __builtin_amdgcn_global_load_lds((const unsigned*)((const char*)(gbase) + (voff)[_i]), (PG8_LAS unsigned*)(lds + (bufoff) + ldsw + _i * 8192), 16, 0, 0); } while (0)
#define PG8_LDA(dst, b, h) do { _Pragma("unroll") for (int m = 0; m < 4; ++m) _Pragma("unroll") for (int k = 0; k < 2; ++k) dst[m][k] = *(const PG8_LAS bf16x8*)(lds + PG8_SA(b, h) + aoff + m * 2048 + k * 1024); } while (0)
#define PG8_LDB(dst, b, h) do { _Pragma("unroll") for (int n = 0; n < 2; ++n) _Pragma("unroll") for (int k = 0; k < 2; ++k) dst[n][k] = *(const PG8_LAS bf16x8*)(lds + PG8_SB(b, h) + boff + n * 2048 + k * 1024); } while (0)
#define PG8_MMA(ai, bj, At, Bt) do { __builtin_amdgcn_s_setprio(1); _Pragma("unroll") for (int m = 0; m < 4; ++m) _Pragma("unroll") for (int n = 0; n < 2; ++n) _Pragma("unroll") for (int k = 0; k < 2; ++k) \
        acc[ai][bj][m][n] = __builtin_amdgcn_mfma_f32_16x16x32_bf16(Bt[n][k], At[m][k], acc[ai][bj][m][n], 0, 0, 0); __builtin_amdgcn_s_setprio(0); } while (0)
#define PG8_WAIT_V(n) asm volatile("s_waitcnt vmcnt(" #n ")" ::: "memory")
#define PG8_WAIT_L(n) asm volatile("s_waitcnt lgkmcnt(" #n ")" ::: "memory")
#define PG8_BAR __builtin_amdgcn_s_barrier()
#define PG8_SCHED __builtin_amdgcn_sched_barrier(0)
    Unit cur, nxt; int ui = 0;
    if (!S.next(0, cur)) return;
    f32x4 acc[2][2][4][2];
#pragma unroll
    for (int a = 0; a < 2; ++a)
#pragma unroll
        for (int b = 0; b < 2; ++b)
#pragma unroll
            for (int m = 0; m < 4; ++m)
#pragma unroll
                for (int n = 0; n < 2; ++n) acc[a][b][m][n] = (f32x4){0.f, 0.f, 0.f, 0.f};
    bf16x8 At[4][2], B0[2][2], B1[2][2];
    const char* cA = (const char*)g.A + (size_t)cur.pm * tstep; const char* cB = (const char*)g.Bt + (size_t)cur.pn * tstep;
    S.a_ready(cur);
    if constexpr (SP2) {
        PG8_STAGE(PG8_SB(0, 0), cB, voffB); PG8_STAGE(PG8_SB(0, 1), cB + hstep, voffB); PG8_STAGE(PG8_SA(0, 0), cA, voffA); PG8_STAGE(PG8_SA(0, 1), cA + hstep, voffA);
        if (wr == 1) PG8_BAR;
        PG8_WAIT_V(2); PG8_BAR;
        PG8_STAGE(PG8_SB(1, 0), cB + kstep, voffB); PG8_STAGE(PG8_SA(1, 0), cA + kstep, voffA); PG8_STAGE(PG8_SB(1, 1), cB + hstep + kstep, voffB);
        PG8_WAIT_V(6); PG8_BAR;
    } else {
        PG8_STAGE(PG8_SB(0, 0), cB, voffB); PG8_STAGE(PG8_SA(0, 0), cA, voffA); PG8_STAGE(PG8_SB(0, 1), cB + hstep, voffB); PG8_STAGE(PG8_SA(0, 1), cA + hstep, voffA);
        if (wr == 1) PG8_BAR;
        PG8_WAIT_V(4); PG8_BAR;
        PG8_STAGE(PG8_SB(1, 0), cB + kstep, voffB); PG8_STAGE(PG8_SA(1, 0), cA + kstep, voffA); PG8_STAGE(PG8_SB(1, 1), cB + hstep + kstep, voffB);
        PG8_WAIT_V(6); PG8_BAR;
    }
    for (;;) {
        const bool has_next = S.next(ui + 1, nxt);
        const char* nA = has_next ? (const char*)g.A + (size_t)nxt.pm * tstep : cA; const char* nB = has_next ? (const char*)g.Bt + (size_t)nxt.pn * tstep : cB;
        for (int t = 0; t < nt; t += 2) {
            const bool last = (t == nt - 2);
            const char* a1 = cA + (size_t)(t + 1) * kstep;
            const char* a2 = last ? nA : cA + (size_t)(t + 2) * kstep; const char* b2 = last ? nB : cB + (size_t)(t + 2) * kstep;
            const char* a3 = a2 + kstep; const char* b3 = b2 + kstep;
            if (last && has_next) S.a_ready(nxt);
            if constexpr (SP2) {
            PG8_LDB(B0, 0, 0); PG8_LDB(B1, 0, 1); PG8_SCHED; PG8_LDA(At, 0, 0); PG8_STAGE(PG8_SA(1, 1), a1 + hstep, voffA);
            PG8_WAIT_V(8); PG8_WAIT_L(0); PG8_BAR; PG8_MMA(0, 0, At, B0); PG8_MMA(0, 1, At, B1); PG8_BAR; PG8_SCHED;
            PG8_LDA(At, 0, 1); PG8_STAGE(PG8_SB(0, 0), b2, voffB); PG8_STAGE(PG8_SB(0, 1), b2 + hstep, voffB); PG8_STAGE(PG8_SA(0, 0), a2, voffA);
            PG8_WAIT_V(8); PG8_WAIT_L(0); PG8_BAR; PG8_MMA(1, 0, At, B0); PG8_MMA(1, 1, At, B1); PG8_BAR; PG8_SCHED;
            PG8_LDB(B0, 1, 0); PG8_LDB(B1, 1, 1); PG8_SCHED; PG8_LDA(At, 1, 0); PG8_STAGE(PG8_SA(0, 1), a2 + hstep, voffA);
            PG8_WAIT_V(8); PG8_WAIT_L(0); PG8_BAR; PG8_MMA(0, 0, At, B0); PG8_MMA(0, 1, At, B1); PG8_BAR; PG8_SCHED;
            PG8_LDA(At, 1, 1); PG8_STAGE(PG8_SB(1, 0), b3, voffB); PG8_STAGE(PG8_SB(1, 1), b3 + hstep, voffB); PG8_STAGE(PG8_SA(1, 0), a3, voffA);
            PG8_WAIT_V(8); PG8_WAIT_L(0); PG8_BAR; PG8_MMA(1, 0, At, B0); PG8_MMA(1, 1, At, B1); PG8_BAR; PG8_SCHED;
            } else {
            PG8_LDB(B0, 0, 0); PG8_SCHED; PG8_LDA(At, 0, 0); PG8_STAGE(PG8_SA(1, 1), a1 + hstep, voffA);
            PG8_WAIT_L(8); PG8_BAR; PG8_WAIT_L(0); PG8_MMA(0, 0, At, B0); PG8_BAR; PG8_SCHED;
            PG8_LDB(B1, 0, 1); PG8_STAGE(PG8_SB(0, 0), b2, voffB);
            PG8_BAR; PG8_WAIT_L(0); PG8_MMA(0, 1, At, B1); PG8_BAR;
            PG8_LDA(At, 0, 1); PG8_STAGE(PG8_SA(0, 0), a2, voffA);
            PG8_BAR; PG8_WAIT_L(0); PG8_MMA(1, 0, At, B0); PG8_BAR; PG8_SCHED;
            PG8_STAGE(PG8_SB(0, 1), b2 + hstep, voffB);
            PG8_WAIT_V(6); PG8_BAR; PG8_MMA(1, 1, At, B1); PG8_BAR;
            PG8_LDB(B0, 1, 0); PG8_SCHED; PG8_LDA(At, 1, 0); PG8_STAGE(PG8_SA(0, 1), a2 + hstep, voffA);
            PG8_WAIT_L(8); PG8_BAR; PG8_WAIT_L(0); PG8_MMA(0, 0, At, B0); PG8_BAR; PG8_SCHED;
            PG8_LDB(B1, 1, 1); PG8_STAGE(PG8_SB(1, 0), b3, voffB);
            PG8_BAR; PG8_WAIT_L(0); PG8_MMA(0, 1, At, B1); PG8_BAR;
            PG8_LDA(At, 1, 1); PG8_STAGE(PG8_SA(1, 0), a3, voffA);
            PG8_BAR; PG8_WAIT_L(0); PG8_MMA(1, 0, At, B0); PG8_BAR; PG8_SCHED;
            PG8_STAGE(PG8_SB(1, 1), b3 + hstep, voffB);
            PG8_WAIT_V(6); PG8_BAR; PG8_MMA(1, 1, At, B1); PG8_BAR;
            }
        }
        if constexpr (ALIGN_EPI) { if (wr == 0) PG8_BAR; }
        if constexpr (!Epi::AFTER_DRAIN) { E(acc, cur, wr, wc, fr, fq); S.done(cur); }
        if (!has_next) break;
#pragma unroll
        for (int a = 0; a < 2; ++a)
#pragma unroll
            for (int b = 0; b < 2; ++b)
#pragma unroll
                for (int m = 0; m < 4; ++m)
#pragma unroll
                    for (int n = 0; n < 2; ++n) acc[a][b][m][n] = (f32x4){0.f, 0.f, 0.f, 0.f};
        cur = nxt; cA = nA; cB = nB; ++ui;
        if constexpr (ALIGN_EPI) { if (wr == 1) PG8_BAR; }
    }
    PG8_WAIT_V(0);
    if constexpr (!ALIGN_EPI) { if (wr == 0) PG8_BAR; }
    PG8_BAR;
    if constexpr (Epi::AFTER_DRAIN) { E.fused(acc, cur, wr, wc, fr, fq, lds, wid, lane); S.done(cur); }
#undef PG8_SA
#undef PG8_SB
#undef PG8_STAGE
#undef PG8_LDA
#undef PG8_LDB
#undef PG8_MMA
#undef PG8_WAIT_V
#undef PG8_WAIT_L
#undef PG8_BAR
#undef PG8_SCHED
}
}

#define LAS __attribute__((address_space(3)))
typedef unsigned short bf16;
typedef short bf16x8 __attribute__((ext_vector_type(8)));
typedef short s16x4 __attribute__((ext_vector_type(4)));
typedef float f32x4 __attribute__((ext_vector_type(4)));
typedef float f32x16 __attribute__((ext_vector_type(16)));
typedef float f32x2_t __attribute__((ext_vector_type(2)));
typedef __bf16 bf16x2_t __attribute__((ext_vector_type(2)));
typedef unsigned u32x4 __attribute__((ext_vector_type(4)));
typedef unsigned u32x2 __attribute__((ext_vector_type(2)));

constexpr int M = 16384, DM = 1024, SEQ = 2048, NB = 8, FF = 4096;
constexpr float RMS_EPS = 1e-6f;
constexpr float LOG2E = 1.4426950408889634f;
constexpr int NWAVES = 8, NTHREADS = 512;
constexpr int LDS_BYTES = 147456;

__device__ __forceinline__ unsigned pk2(float lo, float hi) { f32x2_t v = {lo, hi}; return __builtin_bit_cast(unsigned, __builtin_convertvector(v, bf16x2_t)); }
__device__ __forceinline__ float bf2f(unsigned short b) { return __uint_as_float(((unsigned)b) << 16); }
__device__ __forceinline__ int lane_id_here() { int z = 0; asm volatile("" : "+v"(z)); return __builtin_amdgcn_mbcnt_hi(-1, __builtin_amdgcn_mbcnt_lo(-1, z)); }
__device__ __forceinline__ float shfl_idx(float v, int src) { return __int_as_float(__builtin_amdgcn_ds_bpermute(src << 2, __float_as_int(v))); }
__device__ __forceinline__ float shfl_xor_l(float v, int mask, int lane) { return shfl_idx(v, lane ^ mask); }
__device__ __forceinline__ float wave_sum(float v) {
    const int l = lane_id_here();
#pragma unroll
    for (int o = 1; o < 64; o <<= 1) v += shfl_xor_l(v, o, l);
    return v;
}

constexpr size_t MiB = 1u << 20;
constexpr size_t WS_TABP = 1 * MiB;
constexpr size_t WS_TABL = WS_TABP + 2048 * 16 * 4;
constexpr size_t WS_LSE = 2 * MiB;
constexpr size_t WS_W = 4 * MiB;
constexpr size_t W_A_QK = WS_W;
constexpr size_t W_A_V = W_A_QK + 4 * MiB;
constexpr size_t W_A_O = W_A_V + 2 * MiB;
constexpr size_t W_B_IN = W_A_O + 2 * MiB;
constexpr size_t W_B_UQ = W_B_IN + 1 * MiB;
constexpr size_t W_B_K = W_B_UQ + 768 * 1024;
constexpr size_t W_B_V = W_B_K + 256 * 1024;
constexpr size_t W_B_O = W_B_V + 256 * 1024;
constexpr size_t W_C_QK = W_B_O + 2 * MiB;
constexpr size_t W_C_V = W_C_QK + 4 * MiB;
constexpr size_t W_C_O = W_C_V + 2 * MiB;
constexpr size_t W_D_QK = W_C_O + 2 * MiB;
constexpr size_t W_D_V = W_D_QK + 4 * MiB;
constexpr size_t W_D_O = W_D_V + 2 * MiB;
constexpr size_t W_L = W_D_O + 2 * MiB;
constexpr size_t W_L_STRIDE = 8 * MiB + 8 * MiB + 2 * MiB + 512 * 1024;
constexpr size_t W_L_UP = 0, W_L_DOWN = 8 * MiB, W_L_GATE = 16 * MiB, W_L_PROJ = 18 * MiB;
constexpr size_t WS_PB = W_L + 4 * W_L_STRIDE;
constexpr size_t WS_HN = WS_PB + 8 * MiB;
constexpr size_t WS_BIG = WS_HN + 32 * MiB;
constexpr size_t BIG_Q = 0, BIG_K = 48 * MiB, BIG_V = 96 * MiB, BIG_O = 128 * MiB;
constexpr size_t WS_RS = WS_BIG + 160 * MiB;
constexpr size_t WS_END = WS_RS + 3 * MiB;

#define XB_TMO      128
#define XB_XCNT(j)  (256  + 64 * (j))
#define XB_XSUB(j)  (1280 + 64 * (j))
#define XB_XGEN(j)  (2304 + 64 * (j))
#define XB_TOP      3328
#define XB_TOPGEN   3392
#define XCD_BAR_WORDS 3456
#define XB_SPIN_CAP (1u << 18)

__device__ __forceinline__ unsigned xb_ld(unsigned* p)              { return __hip_atomic_load(p, __ATOMIC_RELAXED, __HIP_MEMORY_SCOPE_AGENT); }
__device__ __forceinline__ unsigned xb_add(unsigned* p, unsigned v) { return __hip_atomic_fetch_add(p, v, __ATOMIC_RELAXED, __HIP_MEMORY_SCOPE_AGENT); }
__device__ __forceinline__ unsigned xb_xcc_id() { return (unsigned)__builtin_amdgcn_s_getreg((3 << 11) | 20) & 0xFu; }
#define XB_SPIN(cond, bar) do { unsigned _sp = 0; while (cond) { __builtin_amdgcn_s_sleep(1); \
    if ((++_sp & 255u) == 0u) { if (xb_ld(&(bar)[XB_TMO])) break; if (_sp > XB_SPIN_CAP) { atomicAdd(&(bar)[XB_TMO], 1u); break; } } } } while (0)

struct XcdBarrier {
    unsigned* bar; unsigned x;
    volatile LAS unsigned* st;
};

__device__ __forceinline__ XcdBarrier xcd_barrier_post(unsigned* bar, volatile LAS unsigned* st, bool is_t0) {
    XcdBarrier b; b.bar = bar; b.x = xb_xcc_id(); b.st = st;
    if (is_t0) (void)xb_add(&bar[XB_XCNT(b.x)], 1u);
    return b;
}
__device__ __forceinline__ void xcd_barrier_complete(unsigned* bar, unsigned x, unsigned& nloc, unsigned& nx) {
    const unsigned G = gridDim.x * gridDim.y * gridDim.z;
    unsigned sum, cnt, mine, sp = 0u;
    for (;;) {
        sum = 0u; cnt = 0u; mine = 0u;
#pragma unroll
        for (unsigned j = 0; j < 16; ++j) { const unsigned c = xb_ld(&bar[XB_XCNT(j)]); sum += c; cnt += (c > 0u) ? 1u : 0u; mine = (j == x) ? c : mine; }
        if (sum == G) break;
        __builtin_amdgcn_s_sleep(1);
        if ((++sp & 255u) == 0u) { if (xb_ld(&bar[XB_TMO])) break; if (sp > XB_SPIN_CAP) { atomicAdd(&bar[XB_TMO], 1u); break; } }
    }
    nloc = mine > 0u ? mine : 1u; nx = cnt > 0u ? cnt : 1u;
}

__device__ __forceinline__ void xcd_barrier(const XcdBarrier& b, bool is_t0) {
    asm volatile("s_waitcnt vmcnt(0)" ::: "memory");
    __syncthreads();
    if (is_t0) {
        unsigned* bar = b.bar;
        __builtin_amdgcn_s_waitcnt(0);
        unsigned nloc = b.st[0], nx = b.st[1];
        if (nloc == 0u) { xcd_barrier_complete(bar, b.x, nloc, nx); b.st[0] = nloc; b.st[1] = nx; }
        const unsigned old = xb_add(&bar[XB_XSUB(b.x)], 1u);
        const unsigned gen = old / nloc;
        if (old + 1u == (gen + 1u) * nloc) {
            __builtin_amdgcn_fence(__ATOMIC_RELEASE, "agent");
            asm volatile("s_waitcnt vmcnt(0)" ::: "memory");
            const unsigned og = xb_add(&bar[XB_TOP], 1u);
            const unsigned tg = og / nx;
            if (og + 1u == (tg + 1u) * nx) xb_add(&bar[XB_TOPGEN], 1u);
            else XB_SPIN(xb_ld(&bar[XB_TOPGEN]) == tg, bar);
            __builtin_amdgcn_fence(__ATOMIC_ACQUIRE, "agent");
            xb_add(&bar[XB_XGEN(b.x)], 1u);
            asm volatile("s_waitcnt vmcnt(0)" ::: "memory");
        } else {
            XB_SPIN(xb_ld(&bar[XB_XGEN(b.x)]) == gen, bar);
            __builtin_amdgcn_fence(__ATOMIC_ACQUIRE, "agent");
            asm volatile("s_waitcnt vmcnt(0)" ::: "memory");
        }
    }
    __syncthreads();
}

enum { EPI_QK = 0, EPI_VT, EPI_RESID, EPI_SQRELU, EPI_BF16, EPI_GATE, EPI_F32, EPI_MLAQ };
struct EpiP {
    void* o0; void* o1; const void* aux; const float* tab;
    int ld, qcols, kcols, heads, hstride, rope, dil, dv;
    const float* rs_in;
    float* rs_out;
    bf16* xb_out;
    float qscale;
};
__device__ __forceinline__ int dil_of_head(int head) { return head < 5 ? 1 : (head < 10 ? 4 : 16); }
__device__ __forceinline__ int perm_pos(int s, int dil) { return (s % dil) * (SEQ / dil) + s / dil; }

__device__ __forceinline__ float rowsum16(const float* r) {
    const f32x4 a = *(const f32x4*)r, b = *(const f32x4*)(r + 4), c = *(const f32x4*)(r + 8), d = *(const f32x4*)(r + 12);
    return (((a[0] + a[1]) + (a[2] + a[3])) + ((b[0] + b[1]) + (b[2] + b[3]))) + (((c[0] + c[1]) + (c[2] + c[3])) + ((d[0] + d[1]) + (d[2] + d[3])));
}
template <int MODE> struct Epi {
    static constexpr bool PERM = true, AFTER_DRAIN = false;
    EpiP p;
    struct Pre { f32x4 rs[4]; f32x4 xa[2][2]; u32x4 tw[2]; f32x4 tb[4]; };
    __device__ __forceinline__ void prefetch(Pre& q, const pg8::Unit& u, int wr, int wc, int fr, int fq, int ai, int m) const {
        const int row = u.pm * 256 + ai * 128 + wr * 64 + m * 16 + fr;
        if (MODE != EPI_VT && p.rs_in) { const float* r = p.rs_in + (size_t)row * 16;
#pragma unroll
            for (int j = 0; j < 4; ++j) q.rs[j] = *(const f32x4*)(r + 4 * j); }
        if constexpr (MODE == EPI_RESID || MODE == EPI_GATE) {
#pragma unroll
            for (int bj = 0; bj < 2; ++bj) {
                const int col0 = u.pn * 256 + bj * 128 + wc * 32 + 8 * fq;
                const float* bp = (MODE == EPI_RESID ? (const float*)p.aux : (const float*)p.o0) + (size_t)row * p.ld + col0;
                q.xa[bj][0] = *(const f32x4*)bp; q.xa[bj][1] = *(const f32x4*)(bp + 4);
                if constexpr (MODE == EPI_GATE) q.tw[bj] = *(const u32x4*)((const bf16*)p.aux + (size_t)row * p.ld + col0);
            }
        }
        if constexpr (MODE == EPI_QK) { if (p.rope) { const float* t = p.tab + (row & 2047) * 16;
#pragma unroll
            for (int j = 0; j < 4; ++j) q.tb[j] = *(const f32x4*)(t + 4 * j); } }
    }
    __device__ __forceinline__ void operator()(const pg8::f32x4 (&acc)[2][2][4][2], const pg8::Unit& u, int wr, int wc, int fr_in, int fq_in) const {
        const int l_ = lane_id_here(), fr = l_ & 15, fq = l_ >> 4;
        (void)fr_in; (void)fq_in;
        float rst_tok = 1.f;
        if (MODE == EPI_VT && p.rs_in) rst_tok = rsqrtf(rowsum16(p.rs_in + (size_t)(u.pn * 256 + 128 * (l_ >> 5) + 32 * wc + (l_ & 31)) * 16) * (1.f / DM) + RMS_EPS);
        Pre q0; prefetch(q0, u, wr, wc, fr, fq, 0, 0);
#pragma unroll
        for (int step = 0; step < 8; ++step) {
            const int ai = step >> 2, m = step & 3;
            Pre q1; if (step < 7) prefetch(q1, u, wr, wc, fr, fq, (step + 1) >> 2, (step + 1) & 3);
            {
                const int row = u.pm * 256 + ai * 128 + wr * 64 + m * 16 + fr;
                float rstd = 1.f;
                if (MODE != EPI_VT && p.rs_in) { const f32x4 a = q0.rs[0], b = q0.rs[1], c = q0.rs[2], d = q0.rs[3];
                    rstd = rsqrtf(((((a[0] + a[1]) + (a[2] + a[3])) + ((b[0] + b[1]) + (b[2] + b[3]))) + (((c[0] + c[1]) + (c[2] + c[3])) + ((d[0] + d[1]) + (d[2] + d[3])))) * (1.f / DM) + RMS_EPS); }
                float ss = 0.f;
#pragma unroll
                for (int bj = 0; bj < 2; ++bj) {
                    const int col0 = u.pn * 256 + bj * 128 + wc * 32 + 8 * fq;
                    float v[8];
#pragma unroll
                    for (int j = 0; j < 4; ++j) { v[j] = acc[ai][bj][m][0][j] * rstd; v[4 + j] = acc[ai][bj][m][1][j] * rstd; }
                    if (MODE == EPI_VT && p.rs_in) {
#pragma unroll
                        for (int j = 0; j < 8; ++j) v[j] *= shfl_idx(rst_tok, bj * 32 + 8 * fq + j);
                    }
                    if constexpr (MODE == EPI_QK) {
                        const int b = row >> 11, s = row & 2047;
                        if (col0 < p.qcols) {
#pragma unroll
                            for (int j = 0; j < 8; ++j) v[j] *= p.qscale;
                        }
                        if (p.rope) {
                            float pr[8];
                            { const int ll = l_ ^ 16;
#pragma unroll
                            for (int j = 0; j < 8; ++j) pr[j] = shfl_idx(v[j], ll); }
                            const int d0 = col0 & 63;
                            if (d0 < 16) {
                                const f32x4 c0 = q0.tb[0], c1 = q0.tb[1], s0 = q0.tb[2], s1 = q0.tb[3];
                                const float sg = (d0 == 0) ? -1.f : 1.f;
#pragma unroll
                                for (int j = 0; j < 4; ++j) { v[j] = v[j] * c0[j] + sg * pr[j] * s0[j]; v[4 + j] = v[4 + j] * c1[j] + sg * pr[4 + j] * s1[j]; }
                            }
                        }
                        if (col0 < p.qcols + p.kcols) {
                            const bool isk = col0 >= p.qcols; const int cc = isk ? col0 - p.qcols : col0;
                            const int head = cc >> 6, d0 = cc & 63;
                            int pos = s; if (p.dil) pos = perm_pos(s, dil_of_head(head));
                            bf16* dst = (bf16*)(isk ? p.o1 : p.o0) + ((size_t)(b * p.heads + head) * SEQ + pos) * p.hstride + d0;
                            u32x4 w; w.x = pk2(v[0], v[1]); w.y = pk2(v[2], v[3]); w.z = pk2(v[4], v[5]); w.w = pk2(v[6], v[7]);
                            *(u32x4*)dst = w;
                        }
                    } else if constexpr (MODE == EPI_MLAQ) {
                        const int b = row >> 11, s = row & 2047;
#pragma unroll
                        for (int j = 0; j < 8; ++j) v[j] *= p.qscale;
                        float pr[8];
                        { const int ll = l_ ^ 32;
#pragma unroll
                        for (int j = 0; j < 8; ++j) pr[j] = shfl_idx(v[j], ll); }
                        if (col0 < 1536) {
                            const int head = col0 / 96, w0 = col0 - head * 96;
                            if (w0 >= 64) {
                                const int jj = w0 - 64; const float* t = p.tab + s * 32;
                                const int jb = jj & 15; const float sg = (jj < 16) ? -1.f : 1.f;
                                const f32x4 c0 = *(const f32x4*)(t + jb), c1 = *(const f32x4*)(t + jb + 4), s0 = *(const f32x4*)(t + 16 + jb), s1 = *(const f32x4*)(t + 16 + jb + 4);
#pragma unroll
                                for (int j = 0; j < 4; ++j) { v[j] = v[j] * c0[j] + sg * pr[j] * s0[j]; v[4 + j] = v[4 + j] * c1[j] + sg * pr[4 + j] * s1[j]; }
                            }
                            bf16* dst = (bf16*)p.o0 + ((size_t)(b * 16 + head) * SEQ + s) * 96 + w0;
                            u32x4 w; w.x = pk2(v[0], v[1]); w.y = pk2(v[2], v[3]); w.z = pk2(v[4], v[5]); w.w = pk2(v[6], v[7]);
                            *(u32x4*)dst = w;
                        }
                    } else if constexpr (MODE == EPI_VT) {
                        if (row < p.qcols) {
                            const int head = row / p.dv, d = row - head * p.dv;
                            const int b = col0 >> 11, s0 = col0 & 2047;
                            bf16* base = (bf16*)p.o0 + (size_t)(b * p.heads + head) * p.dv * SEQ + (size_t)d * 64;
                            const int dil = p.dil ? dil_of_head(head) : 1;
                            if (dil == 1) {
                                u32x4 w; w.x = pk2(v[0], v[1]); w.y = pk2(v[2], v[3]); w.z = pk2(v[4], v[5]); w.w = pk2(v[6], v[7]);
                                *(u32x4*)(base + (size_t)(s0 >> 6) * (p.dv * 64) + (s0 & 63)) = w;
                            } else {
#pragma unroll
                                for (int j = 0; j < 8; ++j) { const int pp = perm_pos(s0 + j, dil); base[(size_t)(pp >> 6) * (p.dv * 64) + (pp & 63)] = (bf16)(pk2(v[j], 0.f) & 0xffffu); }
                            }
                        }
                    } else if constexpr (MODE == EPI_RESID) {
                        float* op = (float*)p.o0 + (size_t)row * p.ld + col0;
                        const f32x4 b0 = q0.xa[bj][0], b1 = q0.xa[bj][1];
#pragma unroll
                        for (int j = 0; j < 4; ++j) { v[j] += b0[j]; v[4 + j] += b1[j]; }
                        *(f32x4*)op = (f32x4){v[0], v[1], v[2], v[3]};
                        *(f32x4*)(op + 4) = (f32x4){v[4], v[5], v[6], v[7]};
                        if (p.xb_out) {
                            u32x4 w; w.x = pk2(v[0], v[1]); w.y = pk2(v[2], v[3]); w.z = pk2(v[4], v[5]); w.w = pk2(v[6], v[7]);
                            *(u32x4*)(p.xb_out + (size_t)row * p.ld + col0) = w;
#pragma unroll
                            for (int j = 0; j < 8; ++j) ss += v[j] * v[j];
                        }
                    } else if constexpr (MODE == EPI_SQRELU) {
#pragma unroll
                        for (int j = 0; j < 8; ++j) { const float r = fmaxf(v[j], 0.f); v[j] = r * r; }
                        u32x4 w; w.x = pk2(v[0], v[1]); w.y = pk2(v[2], v[3]); w.z = pk2(v[4], v[5]); w.w = pk2(v[6], v[7]);
                        *(u32x4*)((bf16*)p.o0 + (size_t)row * p.ld + col0) = w;
                    } else if constexpr (MODE == EPI_BF16) {
                        u32x4 w; w.x = pk2(v[0], v[1]); w.y = pk2(v[2], v[3]); w.z = pk2(v[4], v[5]); w.w = pk2(v[6], v[7]);
                        *(u32x4*)((bf16*)p.o0 + (size_t)row * p.ld + col0) = w;
                    } else if constexpr (MODE == EPI_GATE) {
                        float* xp = (float*)p.o0 + (size_t)row * p.ld + col0;
                        const u32x4 tw = q0.tw[bj];
                        float t[8];
                        t[0] = __uint_as_float(tw.x << 16); t[1] = __uint_as_float(tw.x & 0xffff0000u); t[2] = __uint_as_float(tw.y << 16); t[3] = __uint_as_float(tw.y & 0xffff0000u);
                        t[4] = __uint_as_float(tw.z << 16); t[5] = __uint_as_float(tw.z & 0xffff0000u); t[6] = __uint_as_float(tw.w << 16); t[7] = __uint_as_float(tw.w & 0xffff0000u);
                        f32x4 x0 = q0.xa[bj][0], x1 = q0.xa[bj][1];
#pragma unroll
                        for (int j = 0; j < 4; ++j) { x0[j] += t[j] / (1.f + __expf(-v[j])); x1[j] += t[4 + j] / (1.f + __expf(-v[4 + j])); }
                        *(f32x4*)xp = x0; *(f32x4*)(xp + 4) = x1;
                        if (p.xb_out) {
                            u32x4 w; w.x = pk2(x0[0], x0[1]); w.y = pk2(x0[2], x0[3]); w.z = pk2(x1[0], x1[1]); w.w = pk2(x1[2], x1[3]);
                            *(u32x4*)(p.xb_out + (size_t)row * p.ld + col0) = w;
#pragma unroll
                            for (int j = 0; j < 4; ++j) ss += x0[j] * x0[j] + x1[j] * x1[j];
                        }
                    } else if constexpr (MODE == EPI_F32) {
                        float* op = (float*)p.o0 + (size_t)row * p.ld + col0;
                        *(f32x4*)op = (f32x4){v[0], v[1], v[2], v[3]}; *(f32x4*)(op + 4) = (f32x4){v[4], v[5], v[6], v[7]};
                    }
                }
                if ((MODE == EPI_RESID || MODE == EPI_GATE) && p.rs_out) {
                    ss += shfl_idx(ss, l_ ^ 16); ss += shfl_idx(ss, l_ ^ 32);
                    if (fq == 0) p.rs_out[(size_t)row * 16 + u.pn * 4 + wc] = ss;
                }
            }
            asm volatile("" ::: "memory");
            q0 = q1;
        }
    }
};

template <int MODE>
__device__ __forceinline__ void run_gemm_(LAS unsigned char* lds, const bf16* A, const bf16* Bt, int Mr, int Nc, int K, const EpiP& ep, int wave_s) {
    const int tid = wave_s * 64 + lane_id_here();
    int bx = blockIdx.x, gx = gridDim.x; asm volatile("" : "+s"(bx), "+s"(gx));
    pg8::Gemm g{A, Bt, Mr, Nc, K}; pg8::StaticOrder S; S.init(Mr, Nc, gx, bx);
    Epi<MODE> E{ep};
    pg8::gemm_phase<Epi<MODE>, pg8::StaticOrder, true, true>(lds, g, S, E, tid);
}


struct AttnP {
    const bf16* Q; const bf16* K; const bf16* Vt; bf16* O; float* lse;
    const float* rpb; const float* lq1; const float* lk1; const float* lq2; const float* lk2; const float* subln;
    float* stash; float lambda_init; int pad;
};
#define GAS __attribute__((address_space(1)))
__device__ __forceinline__ float vmax3(float a, float b, float c) { float r; asm("v_max3_f32 %0, %1, %2, %3" : "=v"(r) : "v"(a), "v"(b), "v"(c)); return r; }
__device__ __forceinline__ float vmax16(float m, const f32x16& s) {
    asm("v_max3_f32 %0, %1, %2, %0\n\tv_max3_f32 %0, %3, %4, %0\n\tv_max3_f32 %0, %5, %6, %0\n\tv_max3_f32 %0, %7, %8, %0\n\t"
        "v_max3_f32 %0, %9, %10, %0\n\tv_max3_f32 %0, %11, %12, %0\n\tv_max3_f32 %0, %13, %14, %0\n\tv_max3_f32 %0, %15, %16, %0"
        : "+v"(m) : "v"(s[0]), "v"(s[1]), "v"(s[2]), "v"(s[3]), "v"(s[4]), "v"(s[5]), "v"(s[6]), "v"(s[7]), "v"(s[8]), "v"(s[9]), "v"(s[10]), "v"(s[11]), "v"(s[12]), "v"(s[13]), "v"(s[14]), "v"(s[15]));
    return m;
}
__device__ __forceinline__ float halfmax3(float m_other, float x) {
    const auto r = __builtin_amdgcn_permlane32_swap(__float_as_uint(x), __float_as_uint(x), false, false);
    return vmax3(m_other, __uint_as_float(r[0]), __uint_as_float(r[1]));
}
#define MFMA32(a, b, c) __builtin_amdgcn_mfma_f32_32x32x16_bf16((a), (b), (c), 0, 0, 0)

template <int MODE>
__device__ __forceinline__ void attn_phase_(LAS unsigned char* lds, const AttnP& P, const int tid_in) {
    constexpr int DQ = (MODE == 1) ? 96 : 64, DV = (MODE == 3) ? 128 : 64;
    constexpr int H = (MODE == 0) ? 15 : (MODE == 3 ? 8 : 16);
    constexpr int HQ = (MODE == 3) ? 16 : H;
    constexpr int NPASS = (MODE == 3) ? 2 : 1;
    constexpr int KROW = DQ * 2 + 16, VROW = 136;
    constexpr int NKS = DQ / 16, NDB = DV / 32;
    constexpr int KCH = 64 * (DQ / 8);
    constexpr int VCH = DV * 8;
    constexpr int NU = NB * H * 8;
    constexpr int KBUF = 64 * KROW, VBUF = DV * VROW;
    constexpr int K_OFF = 0, V_OFF = 2 * 13312, B_OFF = V_OFF + 2 * 17408;
    static_assert(KBUF <= 13312 && VBUF <= 17408, "attention LDS map");
    int tid_o = tid_in; asm volatile("" : "+v"(tid_o));
    const int tid = tid_o, lane = tid & 63, wave = __builtin_amdgcn_readfirstlane(tid >> 6), r32 = lane & 31, h = lane >> 5;
    LAS float* ldsB = (LAS float*)(lds + B_OFF);

    if (wave >= 4) __builtin_amdgcn_s_setprio(1);
    float lam = 0.f;
    if constexpr (MODE == 3) {
        const float a1 = wave_sum(P.lq1[lane] * P.lk1[lane]), a2 = wave_sum(P.lq2[lane] * P.lk2[lane]);
        lam = __expf(a1) - __expf(a2) + P.lambda_init;
    }

    int bx = blockIdx.x, gx = gridDim.x; asm volatile("" : "+s"(bx), "+s"(gx));
    const bool xmap = (gx & 7) == 0; const int xcd = bx & 7, nslot = gx >> 3;
    for (int it = xmap ? (bx >> 3) : bx; ; it += xmap ? nslot : gx) {
        int unit;
        if (xmap) { const int bh_ = (it >> 3) * 8 + xcd; if (bh_ >= NB * H) break; unit = bh_ * 8 + (it & 7); } else { if (it >= NU) break; unit = it; }
        const int qb = unit & 7, bh = unit >> 3, head = bh % H, b = bh / H;
        int kt_lo = 0, kt_hi = 32;
        if constexpr (MODE == 0) { kt_lo = max(0, qb * 4 - 1); kt_hi = min(32, qb * 4 + 5); }
        if constexpr (MODE == 2) { const int r0 = qb * 4; kt_lo = min(max(r0 - 4, 0), 24); kt_hi = min(max(r0 - 1, 0), 24) + 8; }
        const int wq0 = qb * 256 + wave * 32, qpos = wq0 + r32;
        int dil = 1, L = SEQ;
        if constexpr (MODE == 0) { dil = dil_of_head(head); L = SEQ / dil; }
        int qr = 0, qc = 0, rs = 0, win0 = 0;
        if constexpr (MODE == 2) { qr = qpos >> 6; qc = qpos & 63; rs = min(max(qr - 4, 0), 24); win0 = min(max(qc - 8, 0), 48); }
        if constexpr (MODE == 2) {
            __syncthreads();
            for (int i = tid; i < 15 * 31; i += NTHREADS) ldsB[i] = P.rpb[head * 465 + i] * LOG2E;
        }
#pragma nounroll
        for (int pass = 0; pass < NPASS; ++pass) {
            const int hq = (MODE == 3) ? 2 * head + pass : head;
            const bf16* Qp = P.Q + (size_t)(b * HQ + hq) * SEQ * DQ;
            const bf16* Kp = P.K + (size_t)(b * HQ + hq) * SEQ * DQ;
            const bf16* Vp = P.Vt + (size_t)(b * H + head) * DV * SEQ;
            bf16x8 qf[NKS];
#pragma unroll
            for (int ks = 0; ks < NKS; ++ks) qf[ks] = *(const GAS bf16x8*)(Qp + (size_t)qpos * DQ + ks * 16 + h * 8);
            f32x16 O[NDB];
#pragma unroll
            for (int db = 0; db < NDB; ++db)
#pragma unroll
                for (int i = 0; i < 16; ++i) O[db][i] = 0.f;
            float mrun = -1e30f, lsum = 0.f;
            u32x4 kreg0, kreg1, vreg0, vreg1;
            const int kc0 = tid, kc1 = tid + 512;
            const int kr0 = kc0 / (DQ / 8), kcc0 = kc0 % (DQ / 8), kr1 = kc1 / (DQ / 8), kcc1 = kc1 % (DQ / 8);
            const int vd0 = tid >> 3, vcc = tid & 7, vd1 = vd0 + 64;
#define GLOAD_K(kt_) do { const bf16* kb = Kp + (size_t)(kt_) * 64 * DQ; \
                kreg0 = *(const GAS u32x4*)(kb + kr0 * DQ + kcc0 * 8); \
                if (KCH > 512 && kc1 < KCH) kreg1 = *(const GAS u32x4*)(kb + kr1 * DQ + kcc1 * 8); } while (0)
#define GLOAD_V(kt_) do { const bf16* vb = Vp + (size_t)(kt_) * (DV * 64);     \
                vreg0 = *(const GAS u32x4*)(vb + vd0 * 64 + vcc * 8); \
                if (VCH > 512) vreg1 = *(const GAS u32x4*)(vb + vd1 * 64 + vcc * 8); } while (0)
#define LSTORE_K(buf_) do { LAS unsigned char* kB = lds + K_OFF + (buf_) * 13312; \
                *(LAS u32x4*)(kB + kr0 * KROW + kcc0 * 16) = kreg0; \
                if (KCH > 512 && kc1 < KCH) *(LAS u32x4*)(kB + kr1 * KROW + kcc1 * 16) = kreg1; } while (0)
#define LSTORE_V(buf_) do { LAS unsigned char* vB = lds + V_OFF + (buf_) * 17408; \
                { LAS unsigned char* vp = vB + vd0 * VROW + vcc * 16; *(LAS u32x2*)vp = (u32x2){vreg0.x, vreg0.y}; *(LAS u32x2*)(vp + 8) = (u32x2){vreg0.z, vreg0.w}; } \
                if (VCH > 512) { LAS unsigned char* vp = vB + vd1 * VROW + vcc * 16; *(LAS u32x2*)vp = (u32x2){vreg1.x, vreg1.y}; *(LAS u32x2*)(vp + 8) = (u32x2){vreg1.z, vreg1.w}; } } while (0)
#define QK_TILE(S0_, S1_, kb_) do { const LAS unsigned char* ldsK = lds + K_OFF + (kb_) * 13312; \
                _Pragma("unroll") for (int i = 0; i < 16; ++i) { S0_[i] = 0.f; S1_[i] = 0.f; } \
                _Pragma("unroll") for (int ks = 0; ks < NKS; ++ks) { \
                    const bf16x8 a0 = *(const LAS bf16x8*)(ldsK + r32 * KROW + ks * 32 + h * 16); \
                    const bf16x8 a1 = *(const LAS bf16x8*)(ldsK + (32 + r32) * KROW + ks * 32 + h * 16); \
                    S0_ = MFMA32(a0, qf[ks], S0_); S1_ = MFMA32(a1, qf[ks], S1_); } } while (0)
#define TILE_SKIP(kt_) ((MODE == 0) ? (((kt_) * 64 > wq0 + 95) || ((kt_) * 64 + 63 < wq0 - 64) || (((kt_) * 64) / L != wq0 / L)) : \
                        (MODE == 2) ? (((kt_) < rs_u) || ((kt_) >= rs_u + 8)) : false)
            const int rs_u = (MODE == 2) ? __builtin_amdgcn_readfirstlane(rs) : 0;
            GLOAD_K(kt_lo); GLOAD_V(kt_lo);
            __syncthreads();
            LSTORE_K(0); LSTORE_V(0);
            if (kt_lo + 1 < kt_hi) GLOAD_K(kt_lo + 1);
            __syncthreads();
            f32x16 s0, s1;
#pragma unroll
            for (int i = 0; i < 16; ++i) { s0[i] = 0.f; s1[i] = 0.f; }
            if (!TILE_SKIP(kt_lo)) QK_TILE(s0, s1, 0);
            if (kt_lo + 1 < kt_hi) { LSTORE_K(1); GLOAD_V(kt_lo + 1); if (kt_lo + 2 < kt_hi) GLOAD_K(kt_lo + 2); }
            __syncthreads();
            for (int kt = kt_lo; kt < kt_hi; ++kt) {
                const int j = kt - kt_lo;
                const LAS unsigned char* ldsV = lds + V_OFF + (j & 1) * 17408;
                const LAS unsigned char* ldsKn = lds + K_OFF + ((j + 1) & 1) * 13312;
                const int key0 = kt * 64;
                constexpr bool DENSE = (MODE == 1 || MODE == 3);
                const bool do_cur = DENSE ? true : !TILE_SKIP(kt), do_nxt = DENSE ? true : ((kt + 1 < kt_hi) && !TILE_SKIP(kt + 1));
                constexpr int KPRE = (MODE == 1) ? NKS : ((MODE == 3) ? 0 : 2), VPRE = (NDB > 2) ? 1 : 2;
                bf16x8 kf[KPRE > 0 ? KPRE : 1][2]; u32x4 vf[VPRE > 0 ? VPRE : 1][NDB];
#define KFRAG(ks_, hf_) (*(const LAS bf16x8*)(ldsKn + ((hf_) * 32 + r32) * KROW + (ks_) * 32 + h * 16))
                if (do_nxt) {
#pragma unroll
                    for (int ks = 0; ks < KPRE; ++ks) { kf[ks][0] = KFRAG(ks, 0); kf[ks][1] = KFRAG(ks, 1); }
                }
#define VFRAG(c_, db_) ({ const LAS unsigned char* vp_ = ldsV + ((db_) * 32 + r32) * VROW + ((c_) * 16 + 4 * h) * 2; \
                          const u32x2 lo_ = *(const LAS u32x2*)vp_, hi_ = *(const LAS u32x2*)(vp_ + 16); (u32x4){lo_.x, lo_.y, hi_.x, hi_.y}; })
                if (do_cur) {
#pragma unroll
                    for (int c = 0; c < VPRE; ++c)
#pragma unroll
                        for (int db = 0; db < NDB; ++db) vf[c][db] = VFRAG(c, db);
                }
                __builtin_amdgcn_sched_barrier(0);
                u32x4 pw[4];
                if (do_cur) {
                    float mx = -INFINITY;
#pragma unroll
                    for (int i = 0; i < 16; ++i) {
                        float v0 = s0[i], v1 = s1[i];
                        if constexpr (MODE == 0) {
                            const int kl = (i & 3) + 8 * (i >> 2) + 4 * h;
                            const int d0 = qpos - (key0 + kl), d1 = d0 - 32;
                            if (d0 > 64 || d0 < -64) v0 = -INFINITY;
                            if (d1 > 64 || d1 < -64) v1 = -INFINITY;
                        }
                        if constexpr (MODE == 2) {
                            const int kl = (i & 3) + 8 * (i >> 2) + 4 * h;
                            const int c0 = kl, c1 = kl + 32; const int rb = (kt - qr + 7) * 31 + 15 - qc;
                            v0 = (c0 >= win0 && c0 < win0 + 16) ? v0 + ldsB[rb + c0] : -INFINITY;
                            v1 = (c1 >= win0 && c1 < win0 + 16) ? v1 + ldsB[rb + c1] : -INFINITY;
                        }
                        s0[i] = v0; s1[i] = v1;
                    }
                    mx = vmax16(vmax16(mx, s0), s1);
                    const float mnew = halfmax3(mrun, mx);
                    if (__builtin_amdgcn_ballot_w64(mnew > mrun + 8.f) != 0ull) {
                        const float alpha = __builtin_amdgcn_exp2f(mrun - mnew);
                        lsum *= alpha;
#pragma unroll
                        for (int db = 0; db < NDB; ++db)
#pragma unroll
                            for (int i = 0; i < 16; ++i) O[db][i] *= alpha;
                        mrun = mnew;
                    }
                }
                f32x16 n0, n1;
#pragma unroll
                for (int i = 0; i < 16; ++i) { n0[i] = 0.f; n1[i] = 0.f; }
                if (do_nxt) {
#pragma unroll
                    for (int ks = 0; ks < KPRE; ++ks) { n0 = MFMA32(kf[ks][0], qf[ks], n0); n1 = MFMA32(kf[ks][1], qf[ks], n1); }
#pragma unroll
                    for (int ks = KPRE; ks < NKS; ++ks) { const bf16x8 a0 = KFRAG(ks, 0), a1 = KFRAG(ks, 1); n0 = MFMA32(a0, qf[ks], n0); n1 = MFMA32(a1, qf[ks], n1); }
                }
                if (do_cur) {
                    float rsum = 0.f;
#pragma unroll
                    for (int i = 0; i < 16; ++i) { s0[i] = __builtin_amdgcn_exp2f(s0[i] - mrun); s1[i] = __builtin_amdgcn_exp2f(s1[i] - mrun); rsum += s0[i] + s1[i]; }
                    lsum += rsum;
                    pw[0] = (u32x4){pk2(s0[0], s0[1]), pk2(s0[2], s0[3]), pk2(s0[4], s0[5]), pk2(s0[6], s0[7])};
                    pw[1] = (u32x4){pk2(s0[8], s0[9]), pk2(s0[10], s0[11]), pk2(s0[12], s0[13]), pk2(s0[14], s0[15])};
                    pw[2] = (u32x4){pk2(s1[0], s1[1]), pk2(s1[2], s1[3]), pk2(s1[4], s1[5]), pk2(s1[6], s1[7])};
                    pw[3] = (u32x4){pk2(s1[8], s1[9]), pk2(s1[10], s1[11]), pk2(s1[12], s1[13]), pk2(s1[14], s1[15])};
                }
                if constexpr (MODE == 1) {
#pragma unroll
                    for (int g = 0; g < 2 * NKS; ++g) { __builtin_amdgcn_sched_group_barrier(0x008, 1, 0); __builtin_amdgcn_sched_group_barrier(0x002, 7, 0); }
                }
                if (do_cur) {
#pragma unroll
                    for (int c = 0; c < VPRE; ++c)
#pragma unroll
                        for (int db = 0; db < NDB; ++db) O[db] = MFMA32(__builtin_bit_cast(bf16x8, vf[c][db]), __builtin_bit_cast(bf16x8, pw[c]), O[db]);
#pragma unroll
                    for (int c = VPRE; c < 4; ++c) {
                        u32x4 vg[NDB];
#pragma unroll
                        for (int db = 0; db < NDB; ++db) vg[db] = VFRAG(c, db);
#pragma unroll
                        for (int db = 0; db < NDB; ++db) O[db] = MFMA32(__builtin_bit_cast(bf16x8, vg[db]), __builtin_bit_cast(bf16x8, pw[c]), O[db]);
                    }
                }
#undef VFRAG
#undef KFRAG
                s0 = n0; s1 = n1;
                if (kt + 2 < kt_hi) LSTORE_K(j & 1);
                if (kt + 1 < kt_hi) LSTORE_V((j + 1) & 1);
                if (kt + 3 < kt_hi) GLOAD_K(kt + 3);
                if (kt + 2 < kt_hi) GLOAD_V(kt + 2);
                asm volatile("s_waitcnt lgkmcnt(0)" ::: "memory"); __builtin_amdgcn_s_barrier(); asm volatile("" ::: "memory");
            }
            const float ltot = lsum + shfl_idx(lsum, lane ^ 32), inv = 1.f / ltot;
#pragma unroll
            for (int db = 0; db < NDB; ++db)
#pragma unroll
                for (int i = 0; i < 16; ++i) O[db][i] *= inv;
            if constexpr (MODE == 3) {
                f32x4* stp = (f32x4*)(P.stash + ((size_t)bx * NTHREADS + tid) * 64);
                if (pass == 0) {
#pragma unroll
                    for (int db = 0; db < NDB; ++db)
#pragma unroll
                        for (int g = 0; g < 4; ++g) stp[db * 4 + g] = (f32x4){O[db][4 * g], O[db][4 * g + 1], O[db][4 * g + 2], O[db][4 * g + 3]};
                } else {
                    float ss = 0.f;
#pragma unroll
                    for (int db = 0; db < NDB; ++db) {
#pragma unroll
                        for (int g = 0; g < 4; ++g) { const f32x4 st = stp[db * 4 + g];
#pragma unroll
                            for (int j = 0; j < 4; ++j) { const float o = st[j] - lam * O[db][4 * g + j]; O[db][4 * g + j] = o; ss += o * o; } }
                        asm volatile("" ::: "memory");
                    }
                    ss += shfl_idx(ss, lane ^ 32);
                    const float rstd = rsqrtf(ss * (1.f / 128.f) + RMS_EPS) * (1.f - P.lambda_init);
                    bf16* orow = P.O + (size_t)(b * SEQ + qpos) * DM + head * 128;
#pragma unroll
                    for (int db = 0; db < NDB; ++db)
#pragma unroll
                        for (int g = 0; g < 4; ++g) {
                            const int d = db * 32 + 8 * g + 4 * h;
                            const f32x4 gn = *(const f32x4*)(P.subln + d);
                            u32x2 w; w.x = pk2(O[db][4 * g] * rstd * gn[0], O[db][4 * g + 1] * rstd * gn[1]); w.y = pk2(O[db][4 * g + 2] * rstd * gn[2], O[db][4 * g + 3] * rstd * gn[3]);
                            *(u32x2*)(orow + d) = w;
                        }
                }
            } else {
                int tok = qpos;
                if constexpr (MODE == 0) tok = (qpos % L) * dil + qpos / L;
                bf16* orow = P.O + (size_t)(b * SEQ + tok) * DM + head * 64;
#pragma unroll
                for (int db = 0; db < NDB; ++db)
#pragma unroll
                    for (int g = 0; g < 4; ++g) {
                        const int d = db * 32 + 8 * g + 4 * h;
                        u32x2 w; w.x = pk2(O[db][4 * g], O[db][4 * g + 1]); w.y = pk2(O[db][4 * g + 2], O[db][4 * g + 3]);
                        *(u32x2*)(orow + d) = w;
                    }
                if constexpr (MODE == 0) { if (h == 0) P.lse[(size_t)head * M + b * SEQ + tok] = mrun * (1.f / LOG2E) + __logf(ltot); }
            }
        }
    }
    __builtin_amdgcn_s_setprio(0);
    __syncthreads();
#undef GLOAD_K
#undef GLOAD_V
#undef LSTORE_K
#undef LSTORE_V
#undef QK_TILE
#undef TILE_SKIP
}

__device__ __forceinline__ void tr_item(const float* W, int ldw, int col0, bf16* WT, int ldt, int row0, int k0, int n0, LAS float* scr, int lane, const float* gain) {
    const int c = lane & 7;
    f32x4 g0 = {1.f, 1.f, 1.f, 1.f}, g1 = g0;
    if (gain) { g0 = *(const f32x4*)(gain + k0 + 8 * c); g1 = *(const f32x4*)(gain + k0 + 8 * c + 4); }
    float wv[32];
    const float* wp = W + (size_t)(k0 + (lane >> 5)) * ldw + col0 + n0 + (lane & 31);
#pragma unroll
    for (int i = 0; i < 32; ++i) wv[i] = wp[(size_t)(2 * i) * ldw];
#pragma unroll
    for (int i = 0; i < 32; ++i) scr[(2 * i + (lane >> 5)) * 33 + (lane & 31)] = wv[i];
    asm volatile("s_waitcnt lgkmcnt(0)" ::: "memory");
#pragma unroll
    for (int j = 0; j < 4; ++j) { const int n = (lane >> 3) + 8 * j; const LAS float* s = scr + (8 * c) * 33 + n;
        u32x4 o; o.x = pk2(s[0 * 33] * g0[0], s[1 * 33] * g0[1]); o.y = pk2(s[2 * 33] * g0[2], s[3 * 33] * g0[3]); o.z = pk2(s[4 * 33] * g1[0], s[5 * 33] * g1[1]); o.w = pk2(s[6 * 33] * g1[2], s[7 * 33] * g1[3]);
        *(u32x4*)(WT + (size_t)(row0 + n0 + n) * ldt + k0 + 8 * c) = o; }
    asm volatile("s_waitcnt lgkmcnt(0)" ::: "memory");
}
__device__ __forceinline__ void tr_job(const float* W, int ldw, int col0, int ncols, int K, bf16* WT, int ldt, int row0, LAS float* scr, int lane, int gw, int ngw, const float* gain) {
    const int nblk = ncols / 32, nitems = (K / 64) * nblk;
    for (int it = gw; it < nitems; it += ngw) { const int kb = it / nblk, nb = it - kb * nblk; tr_item(W, ldw, col0, WT, ldt, row0, 64 * kb, 32 * nb, scr, lane, gain); }
}
__device__ __forceinline__ void rms_row_to_bf16(const float* xrow, const float* g, bf16* orow, int lane) {
    const f32x4* xr = (const f32x4*)xrow + lane; const f32x4* gr = (const f32x4*)g + lane;
    f32x4 v[4]; float s = 0.f;
#pragma unroll
    for (int j = 0; j < 4; ++j) { v[j] = xr[64 * j]; s += (v[j].x * v[j].x + v[j].y * v[j].y) + (v[j].z * v[j].z + v[j].w * v[j].w); }
    const float rstd = rsqrtf(wave_sum(s) * (1.f / DM) + RMS_EPS);
    unsigned long long* o8 = (unsigned long long*)orow + lane;
#pragma unroll
    for (int j = 0; j < 4; ++j) { const f32x4 gg = gr[64 * j];
        o8[64 * j] = (unsigned long long)pk2(v[j].x * rstd * gg.x, v[j].y * rstd * gg.y) | ((unsigned long long)pk2(v[j].z * rstd * gg.z, v[j].w * rstd * gg.w) << 32); }
}
__device__ __forceinline__ void norm_pass(const float* X, const float* g, bf16* HN, int lane, int gw, int ngw) {
    for (int m = gw; m < M; m += ngw) rms_row_to_bf16(X + (size_t)m * DM, g, HN + (size_t)m * DM, lane);
}
__device__ __forceinline__ void pconv_pass(const float* Pf, bf16* PB, int lane, int gw, int ngw) {
    for (int m = gw; m < M; m += ngw) { const f32x4 v = *((const f32x4*)(Pf + (size_t)m * 256) + lane);
        *((u32x2*)(PB + (size_t)m * 256) + lane) = (u32x2){pk2(v.x, v.y), pk2(v.z, v.w)}; }
}
__device__ __forceinline__ void final_norm_pass(float* X, const float* g, int lane, int gw, int ngw) {
    for (int m = gw; m < M; m += ngw) {
        f32x4* xr = (f32x4*)(X + (size_t)m * DM) + lane; const f32x4* gr = (const f32x4*)g + lane;
        f32x4 v[4]; float s = 0.f;
#pragma unroll
        for (int j = 0; j < 4; ++j) { v[j] = xr[64 * j]; s += (v[j].x * v[j].x + v[j].y * v[j].y) + (v[j].z * v[j].z + v[j].w * v[j].w); }
        const float rstd = rsqrtf(wave_sum(s) * (1.f / DM) + RMS_EPS);
#pragma unroll
        for (int j = 0; j < 4; ++j) { const f32x4 gg = gr[64 * j]; xr[64 * j] = (f32x4){v[j].x * rstd * gg.x, v[j].y * rstd * gg.y, v[j].z * rstd * gg.z, v[j].w * rstd * gg.w}; }
    }
}
__device__ __forceinline__ void mix_pass(bf16* O, const float* lse, int lane, int gw, int ngw) {
    for (int m = gw; m < M; m += ngw) {
#pragma unroll
        for (int it = 0; it < 2; ++it) {
            const int c = lane + 64 * it;
            u32x4* p = (u32x4*)(O + (size_t)m * DM) + c;
            if (c >= 120) { *p = (u32x4){0u, 0u, 0u, 0u}; continue; }
            const int head = c >> 3, hg = head % 5, g = head / 5;
            const float l0 = lse[(size_t)hg * M + m], l1 = lse[(size_t)(5 + hg) * M + m], l2 = lse[(size_t)(10 + hg) * M + m];
            const float mx = fmaxf(l0, fmaxf(l1, l2)), e0 = __expf(l0 - mx), e1 = __expf(l1 - mx), e2 = __expf(l2 - mx);
            const float a = (g == 0 ? e0 : (g == 1 ? e1 : e2)) / (e0 + e1 + e2);
            u32x4 w = *p;
            w.x = pk2(__uint_as_float(w.x << 16) * a, __uint_as_float(w.x & 0xffff0000u) * a); w.y = pk2(__uint_as_float(w.y << 16) * a, __uint_as_float(w.y & 0xffff0000u) * a);
            w.z = pk2(__uint_as_float(w.z << 16) * a, __uint_as_float(w.z & 0xffff0000u) * a); w.w = pk2(__uint_as_float(w.w << 16) * a, __uint_as_float(w.w & 0xffff0000u) * a);
            *p = w;
        }
    }
}
__device__ __forceinline__ void mla_norm_pass(const float* Z, const float* qg, const float* kvg, const float* tabl, bf16* CQN, bf16* CKVN, bf16* Kb, int lane, int gw, int ngw) {
    for (int m = gw; m < M; m += ngw) {
        const float* z = Z + (size_t)m * 512;
        const f32x4 a = *((const f32x4*)z + lane); const f32x2_t c = *((const f32x2_t*)(z + 256) + lane);
        const float rq = rsqrtf(wave_sum((a.x * a.x + a.y * a.y) + (a.z * a.z + a.w * a.w)) * (1.f / 256.f) + RMS_EPS);
        const float rk = rsqrtf(wave_sum(c.x * c.x + c.y * c.y) * (1.f / 128.f) + RMS_EPS);
        const f32x4 g4 = *((const f32x4*)qg + lane); const f32x2_t g2 = *((const f32x2_t*)kvg + lane);
        *((u32x2*)(CQN + (size_t)m * 256) + lane) = (u32x2){pk2(a.x * rq * g4.x, a.y * rq * g4.y), pk2(a.z * rq * g4.z, a.w * rq * g4.w)};
        *((unsigned*)(CKVN + (size_t)m * 128) + lane) = pk2(c.x * rk * g2.x, c.y * rk * g2.y);
        const int b = m >> 11, s = m & 2047; const int j = lane & 15;
        const float x1 = z[384 + j], x2 = z[400 + j], cs = tabl[s * 32 + j], sn = tabl[s * 32 + 16 + j];
        const float o1 = x1 * cs - x2 * sn, o2 = x2 * cs + x1 * sn;
        const int head = lane >> 2, j0 = (lane & 3) * 4;
        float r1[4], r2[4];
#pragma unroll
        for (int q = 0; q < 4; ++q) { r1[q] = shfl_idx(o1, j0 + q); r2[q] = shfl_idx(o2, j0 + q); }
        bf16* kr = Kb + ((size_t)(b * 16 + head) * SEQ + s) * 96 + 64;
        *(u32x2*)(kr + j0) = (u32x2){pk2(r1[0], r1[1]), pk2(r1[2], r1[3])};
        *(u32x2*)(kr + 16 + j0) = (u32x2){pk2(r2[0], r2[1]), pk2(r2[2], r2[3])};
    }
}

__device__ __forceinline__ void xb_rowss_pass(const float* Xs, bf16* XBo, float* RS, int lane, int gw, int ngw) {
    for (int m = gw; m < M; m += ngw) {
        const f32x4* xr = (const f32x4*)(Xs + (size_t)m * DM) + lane; f32x4 v[4]; float s = 0.f;
#pragma unroll
        for (int j = 0; j < 4; ++j) { v[j] = xr[64 * j]; s += (v[j].x * v[j].x + v[j].y * v[j].y) + (v[j].z * v[j].z + v[j].w * v[j].w); }
        s = wave_sum(s);
        unsigned long long* o8 = (unsigned long long*)(XBo + (size_t)m * DM) + lane;
#pragma unroll
        for (int j = 0; j < 4; ++j) o8[64 * j] = (unsigned long long)pk2(v[j].x, v[j].y) | ((unsigned long long)pk2(v[j].z, v[j].w) << 32);
        if (lane < 16) RS[(size_t)m * 16 + lane] = (lane == 0) ? s : 0.f;
    }
}
__device__ __forceinline__ void final_norm_rs_pass(float* Xs, const float* g, const float* RS, int lane, int gw, int ngw) {
    for (int m = gw; m < M; m += ngw) {
        f32x4* xr = (f32x4*)(Xs + (size_t)m * DM) + lane; const f32x4* gr = (const f32x4*)g + lane;
        const float rstd = rsqrtf(rowsum16(RS + (size_t)m * 16) * (1.f / DM) + RMS_EPS);
#pragma unroll
        for (int j = 0; j < 4; ++j) { const f32x4 v = xr[64 * j], gg = gr[64 * j]; xr[64 * j] = (f32x4){v.x * rstd * gg.x, v.y * rstd * gg.y, v.z * rstd * gg.z, v.w * rstd * gg.w}; }
    }
}

struct TrState { float wv[32]; f32x4 g0, g1; bf16* dst; int ldt; };
struct TrJob { int idx; unsigned src_off; int ldw, col0, ncols, K; unsigned dst_off; int ldt, row0, gidx, goff, item0; };
constexpr int N_TRJOBS = 60;
constexpr int N_TR_ITEMS = 26000;
__constant__ TrJob tr_jobs[N_TRJOBS + 1] = {
    {3, 0u, 2880, 0, 1920, 1024, 4194304u, 1024, 0, 2, 0, 0},
    {3, 0u, 2880, 1920, 960, 1024, 8388608u, 1024, 0, 2, 0, 960},
    {4, 0u, 1024, 0, 1024, 960, 10485760u, 1024, 0, -1, 0, 1440},
    {6, 0u, 416, 0, 416, 1024, 12582912u, 1024, 0, 5, 0, 1920},
    {8, 0u, 1536, 0, 1536, 256, 13631488u, 256, 0, -1, 0, 2128},
    {10, 0u, 2048, 0, 64, 128, 14417920u, 128, 0, -1, 0, 2320},
    {10, 0u, 2048, 64, 64, 128, 14680064u, 128, 0, -1, 0, 2324},
    {10, 0u, 2048, 128, 64, 128, 14417920u, 128, 64, -1, 0, 2328},
    {10, 0u, 2048, 192, 64, 128, 14680064u, 128, 64, -1, 0, 2332},
    {10, 0u, 2048, 256, 64, 128, 14417920u, 128, 128, -1, 0, 2336},
    {10, 0u, 2048, 320, 64, 128, 14680064u, 128, 128, -1, 0, 2340},
    {10, 0u, 2048, 384, 64, 128, 14417920u, 128, 192, -1, 0, 2344},
    {10, 0u, 2048, 448, 64, 128, 14680064u, 128, 192, -1, 0, 2348},
    {10, 0u, 2048, 512, 64, 128, 14417920u, 128, 256, -1, 0, 2352},
    {10, 0u, 2048, 576, 64, 128, 14680064u, 128, 256, -1, 0, 2356},
    {10, 0u, 2048, 640, 64, 128, 14417920u, 128, 320, -1, 0, 2360},
    {10, 0u, 2048, 704, 64, 128, 14680064u, 128, 320, -1, 0, 2364},
    {10, 0u, 2048, 768, 64, 128, 14417920u, 128, 384, -1, 0, 2368},
    {10, 0u, 2048, 832, 64, 128, 14680064u, 128, 384, -1, 0, 2372},
    {10, 0u, 2048, 896, 64, 128, 14417920u, 128, 448, -1, 0, 2376},
    {10, 0u, 2048, 960, 64, 128, 14680064u, 128, 448, -1, 0, 2380},
    {10, 0u, 2048, 1024, 64, 128, 14417920u, 128, 512, -1, 0, 2384},
    {10, 0u, 2048, 1088, 64, 128, 14680064u, 128, 512, -1, 0, 2388},
    {10, 0u, 2048, 1152, 64, 128, 14417920u, 128, 576, -1, 0, 2392},
    {10, 0u, 2048, 1216, 64, 128, 14680064u, 128, 576, -1, 0, 2396},
    {10, 0u, 2048, 1280, 64, 128, 14417920u, 128, 640, -1, 0, 2400},
    {10, 0u, 2048, 1344, 64, 128, 14680064u, 128, 640, -1, 0, 2404},
    {10, 0u, 2048, 1408, 64, 128, 14417920u, 128, 704, -1, 0, 2408},
    {10, 0u, 2048, 1472, 64, 128, 14680064u, 128, 704, -1, 0, 2412},
    {10, 0u, 2048, 1536, 64, 128, 14417920u, 128, 768, -1, 0, 2416},
    {10, 0u, 2048, 1600, 64, 128, 14680064u, 128, 768, -1, 0, 2420},
    {10, 0u, 2048, 1664, 64, 128, 14417920u, 128, 832, -1, 0, 2424},
    {10, 0u, 2048, 1728, 64, 128, 14680064u, 128, 832, -1, 0, 2428},
    {10, 0u, 2048, 1792, 64, 128, 14417920u, 128, 896, -1, 0, 2432},
    {10, 0u, 2048, 1856, 64, 128, 14680064u, 128, 896, -1, 0, 2436},
    {10, 0u, 2048, 1920, 64, 128, 14417920u, 128, 960, -1, 0, 2440},
    {10, 0u, 2048, 1984, 64, 128, 14680064u, 128, 960, -1, 0, 2444},
    {11, 0u, 1024, 0, 1024, 1024, 14942208u, 1024, 0, -1, 0, 2448},
    {13, 0u, 3072, 0, 2048, 1024, 17039360u, 1024, 0, 12, 0, 2960},
    {13, 0u, 3072, 2048, 1024, 1024, 21233664u, 1024, 0, 12, 0, 3984},
    {15, 0u, 1024, 0, 1024, 1024, 23330816u, 1024, 0, -1, 0, 4496},
    {17, 0u, 3072, 0, 2048, 1024, 25427968u, 1024, 0, 16, 0, 5008},
    {17, 0u, 3072, 2048, 1024, 1024, 29622272u, 1024, 0, 16, 0, 6032},
    {23, 0u, 1024, 0, 1024, 1024, 31719424u, 1024, 0, -1, 0, 6544},
    {25, 0u, 4096, 0, 4096, 1024, 33816576u, 1024, 0, 24, 0, 7056},
    {26, 0u, 1024, 0, 1024, 4096, 42205184u, 4096, 0, -1, 0, 9104},
    {28, 0u, 1024, 0, 1024, 1024, 50593792u, 1024, 0, 27, 0, 11152},
    {29, 0u, 1024, 0, 1024, 256, 52690944u, 256, 0, -1, 0, 11664},
    {25, 4194304u, 4096, 0, 4096, 1024, 53215232u, 1024, 0, 24, 1024, 11792},
    {26, 4194304u, 1024, 0, 1024, 4096, 61603840u, 4096, 0, -1, 0, 13840},
    {28, 1048576u, 1024, 0, 1024, 1024, 69992448u, 1024, 0, 27, 1024, 15888},
    {29, 262144u, 1024, 0, 1024, 256, 72089600u, 256, 0, -1, 0, 16400},
    {25, 8388608u, 4096, 0, 4096, 1024, 72613888u, 1024, 0, 24, 2048, 16528},
    {26, 8388608u, 1024, 0, 1024, 4096, 81002496u, 4096, 0, -1, 0, 18576},
    {28, 2097152u, 1024, 0, 1024, 1024, 89391104u, 1024, 0, 27, 2048, 20624},
    {29, 524288u, 1024, 0, 1024, 256, 91488256u, 256, 0, -1, 0, 21136},
    {25, 12582912u, 4096, 0, 4096, 1024, 92012544u, 1024, 0, 24, 3072, 21264},
    {26, 12582912u, 1024, 0, 1024, 4096, 100401152u, 4096, 0, -1, 0, 23312},
    {28, 3145728u, 1024, 0, 1024, 1024, 108789760u, 1024, 0, 27, 3072, 25360},
    {29, 786432u, 1024, 0, 1024, 256, 110886912u, 256, 0, -1, 0, 25872},
    {0, 0u, 0, 0, 32, 64, 0u, 0, 0, -1, 0, 26000},
};

#ifndef REP_ATTN_A
#define REP_ATTN_A 1
#endif
#ifndef REP_ATTN_B
#define REP_ATTN_B 1
#endif
#ifndef REP_ATTN_C
#define REP_ATTN_C 1
#endif
#ifndef REP_ATTN_D
#define REP_ATTN_D 1
#endif
#ifndef REP_P0
#define REP_P0 1
#endif
#ifndef REP_QKV
#define REP_QKV 1
#endif
#ifndef REP_UP
#define REP_UP 1
#endif
#ifndef REP_SYNC
#define REP_SYNC 1
#endif
struct Args { const float* in[31]; float* out; unsigned char* ws; int ph_lo, ph_hi; };
#define CAS __attribute__((address_space(4)))
__device__ __forceinline__ const float* in_ptr(int idx) {
    const CAS char* ka = (const CAS char*)__builtin_amdgcn_kernarg_segment_ptr(); asm volatile("" : "+s"(ka));
    return (const float*)*(const __attribute__((address_space(1))) float* const CAS*)(ka + idx * 8);
}

__global__ void __launch_bounds__(NTHREADS, 2) fwd_kernel(Args args) {
    extern __shared__ __attribute__((aligned(16))) unsigned char lds_raw[];
    LAS unsigned char* lds = (LAS unsigned char*)lds_raw;
    cg::grid_group grid = cg::this_grid();
#define X ((float*)(__attribute__((address_space(1))) float*)args.out)
#define HN ((bf16*)(ws + WS_HN))
#define PB ((bf16*)(ws + WS_PB))
#define Qb ((bf16*)(ws + WS_BIG + BIG_Q))
#define Kb ((bf16*)(ws + WS_BIG + BIG_K))
#define Vb ((bf16*)(ws + WS_BIG + BIG_V))
#define Ob ((bf16*)(ws + WS_BIG + BIG_O))
#define Hb ((bf16*)(ws + WS_BIG))
#define Tb ((bf16*)(ws + WS_BIG + BIG_O))
#define XBM ((bf16*)(ws + WS_BIG + BIG_O))
#define RS(i) ((float*)(ws + WS_RS) + (size_t)((i) % 3) * M * 16)
#define Zb ((float*)(ws + WS_HN))
#define CQN ((bf16*)(ws + WS_BIG + BIG_O))
#define CKVN ((bf16*)(ws + WS_BIG + BIG_O + 8 * MiB))
#define tabp ((float*)(ws + WS_TABP))
#define tabl ((float*)(ws + WS_TABL))
#define lse ((float*)(ws + WS_LSE))
    const int wave_s = __builtin_amdgcn_readfirstlane(threadIdx.x >> 6);
    volatile LAS unsigned* xb_st = (volatile LAS unsigned*)(lds + 131072 + 64);
    if (threadIdx.x == 0) { xb_st[0] = 0u; xb_st[1] = 0u; }
    __syncthreads();
    XcdBarrier xb = xcd_barrier_post((unsigned*)args.ws, xb_st, threadIdx.x == 0);
    int ph = 0;
#define run_gemm(MODE, ...) run_gemm_<MODE>(__VA_ARGS__, wave_s)
#define attn_phase(MODE, ...) attn_phase_<MODE>(__VA_ARGS__, wave_s * 64 + lane_id_here())
#define PHASE_BEGIN if (ph >= args.ph_lo && ph < args.ph_hi) { __attribute__((address_space(1))) unsigned char* wsg_ = (__attribute__((address_space(1))) unsigned char*)args.ws; int bx_ = blockIdx.x, gx_ = gridDim.x; asm volatile("" : "+s"(wsg_), "+s"(bx_), "+s"(gx_)); unsigned char* ws = (unsigned char*)wsg_; \
    const int lane = lane_id_here(), wave = wave_s, tid = wave * 64 + lane, gw = bx_ * NWAVES + wave, ngw = gx_ * NWAVES; \
    LAS float* scr = (LAS float*)(lds + wave * 16384); (void)scr; (void)lane; (void)gw; (void)ngw;
#define PHASE_BEGIN_R(n) PHASE_BEGIN for (int rp_ = 0; rp_ < (n); ++rp_) {
#define PHASE_END_R } PHASE_END
#define PHASE_END   if (ph + 1 < args.ph_hi) { for (int rs_ = 0; rs_ < REP_SYNC; ++rs_) { if (ph == 0) grid.sync(); else xcd_barrier(xb, wave_s == 0 && lane_id_here() == 0); } } } ++ph;
#define WB(off) ((bf16*)(ws + (off)))
#define TR(idx, ldw, col0, ncols, K, dst, ldt, row0) tr_job(in_ptr(idx), ldw, col0, ncols, K, WB(dst), ldt, row0, scr, lane, gw, ngw)

    PHASE_BEGIN_R(REP_P0)
        {
            int jcur = 0;
#define TR_LOAD(S_, it_) do { while (tr_jobs[jcur + 1].item0 <= (it_)) ++jcur; const TrJob jb = tr_jobs[jcur]; \
                const int loc = (it_) - jb.item0, nblk = jb.ncols >> 5, kb = loc / nblk, nb = loc - kb * nblk, k0 = 64 * kb, n0 = 32 * nb; \
                const float* wp = in_ptr(jb.idx) + jb.src_off + (size_t)(k0 + (lane >> 5)) * jb.ldw + jb.col0 + n0 + (lane & 31); \
                _Pragma("unroll") for (int i = 0; i < 32; ++i) S_.wv[i] = wp[(size_t)(2 * i) * jb.ldw]; \
                S_.g0 = (f32x4){1.f, 1.f, 1.f, 1.f}; S_.g1 = S_.g0; \
                if (jb.gidx >= 0) { const float* gp = in_ptr(jb.gidx) + jb.goff + k0 + 8 * (lane & 7); S_.g0 = *(const f32x4*)gp; S_.g1 = *(const f32x4*)(gp + 4); } \
                S_.dst = (bf16*)(ws + jb.dst_off) + (size_t)(jb.row0 + n0) * jb.ldt + k0 + 8 * (lane & 7); S_.ldt = jb.ldt; } while (0)
#define TR_FINISH(S_) do { _Pragma("unroll") for (int i = 0; i < 32; ++i) scr[(2 * i + (lane >> 5)) * 33 + (lane & 31)] = S_.wv[i]; \
                asm volatile("s_waitcnt lgkmcnt(0)" ::: "memory"); \
                _Pragma("unroll") for (int j = 0; j < 4; ++j) { const int n = (lane >> 3) + 8 * j; const LAS float* sp = scr + (8 * (lane & 7)) * 33 + n; \
                    u32x4 o; o.x = pk2(sp[0 * 33] * S_.g0[0], sp[1 * 33] * S_.g0[1]); o.y = pk2(sp[2 * 33] * S_.g0[2], sp[3 * 33] * S_.g0[3]); \
                    o.z = pk2(sp[4 * 33] * S_.g1[0], sp[5 * 33] * S_.g1[1]); o.w = pk2(sp[6 * 33] * S_.g1[2], sp[7 * 33] * S_.g1[3]); \
                    *(u32x4*)(S_.dst + (size_t)n * S_.ldt) = o; } \
                asm volatile("s_waitcnt lgkmcnt(0)" ::: "memory"); } while (0)
            TrState A, B;
            int it = gw;
            if (it < N_TR_ITEMS) TR_LOAD(A, it);
            while (it < N_TR_ITEMS) {
                int nxt = it + ngw; if (nxt < N_TR_ITEMS) TR_LOAD(B, nxt);
                TR_FINISH(A);
                it = nxt; if (it >= N_TR_ITEMS) break;
                nxt = it + ngw; if (nxt < N_TR_ITEMS) TR_LOAD(A, nxt);
                TR_FINISH(B);
                it = nxt;
            }
#undef TR_LOAD
#undef TR_FINISH
        }
        for (int i = bx_ * NTHREADS + tid; i < 1024 * 8; i += gx_ * NTHREADS) *((u32x4*)(WB(W_A_O) + (size_t)(i >> 3) * 1024 + 960) + (i & 7)) = (u32x4){0u, 0u, 0u, 0u};
        for (int i = bx_ * NTHREADS + tid; i < SEQ * 24; i += gx_ * NTHREADS) {
            const int s = i / 24, r = i - s * 24;
            const bool isl = r >= 8; const int j = isl ? r - 8 : r; const float rot = isl ? 32.f : 16.f;
            const float inv = exp2f(-(2.f * (float)j / rot) * 18.931568569324174f);
            double rev = (double)s * (double)inv * 0.15915494309189535; rev -= floor(rev);
            const float cs = __builtin_amdgcn_cosf((float)rev), sn = __builtin_amdgcn_sinf((float)rev);
            if (isl) { tabl[s * 32 + j] = cs; tabl[s * 32 + 16 + j] = sn; } else { tabp[s * 16 + j] = cs; tabp[s * 16 + 8 + j] = sn; }
        }
        xb_rowss_pass(in_ptr(0), XBM, RS(0), lane, gw, ngw);
    PHASE_END_R

#pragma unroll
    for (int layer = 0; layer < 4; ++layer) {
        if (layer == 0) {
            PHASE_BEGIN_R(REP_QKV)
                { EpiP e{Qb, Kb, nullptr, tabp, 0, 960, 960, 15, 64, 1, 1, 64, RS(0), nullptr, nullptr, LOG2E * 0.125f}; run_gemm(EPI_QK, lds, XBM, WB(W_A_QK), M, 2048, DM, e); }
                { EpiP e{Vb, nullptr, nullptr, nullptr, 0, 960, 0, 15, 0, 0, 1, 64, RS(0), nullptr, nullptr}; run_gemm(EPI_VT, lds, WB(W_A_V), XBM, 1024, M, DM, e); }
            PHASE_END_R
            PHASE_BEGIN
                { AttnP a{Qb, Kb, Vb, Ob, lse, nullptr, nullptr, nullptr, nullptr, nullptr, nullptr, nullptr, 0.f, 0}; for (int rep_ = 0; rep_ < REP_ATTN_A; ++rep_) attn_phase(0, lds, a); }
            PHASE_END
            PHASE_BEGIN
                mix_pass(Ob, lse, lane, gw, ngw);
            PHASE_END
            PHASE_BEGIN
                { EpiP e{X, nullptr, in_ptr(0), nullptr, DM, 0, 0, 0, 0, 0, 0, 0, nullptr, RS(1), HN}; run_gemm(EPI_RESID, lds, Ob, WB(W_A_O), M, DM, DM, e); }
                pconv_pass(in_ptr(1), PB, lane, gw, ngw);
            PHASE_END
        } else if (layer == 1) {
            PHASE_BEGIN
                { EpiP e{Zb, nullptr, nullptr, nullptr, 512, 0, 0, 0, 0, 0, 0, 0, RS(3), nullptr, nullptr}; run_gemm(EPI_F32, lds, XBM, WB(W_B_IN), M, 512, DM, e); }
            PHASE_END
            PHASE_BEGIN
                mla_norm_pass(Zb, in_ptr(7), in_ptr(9), tabl, CQN, CKVN, Kb, lane, gw, ngw);
            PHASE_END
            PHASE_BEGIN
                { EpiP e{Qb, nullptr, nullptr, tabl, 0, 0, 0, 16, 96, 1, 0, 0, nullptr, nullptr, nullptr, LOG2E * 0.10206207261596575f}; run_gemm(EPI_MLAQ, lds, CQN, WB(W_B_UQ), M, 1536, 256, e); }
                { EpiP e{nullptr, Kb, nullptr, nullptr, 0, 0, 1024, 16, 96, 0, 0, 0, nullptr, nullptr, nullptr}; run_gemm(EPI_QK, lds, CKVN, WB(W_B_K), M, 1024, 128, e); }
                { EpiP e{Vb, nullptr, nullptr, nullptr, 0, 1024, 0, 16, 0, 0, 0, 64, nullptr, nullptr, nullptr}; run_gemm(EPI_VT, lds, WB(W_B_V), CKVN, 1024, M, 128, e); }
            PHASE_END
            PHASE_BEGIN
                { AttnP a{Qb, Kb, Vb, Ob, nullptr, nullptr, nullptr, nullptr, nullptr, nullptr, nullptr, nullptr, 0.f, 0}; for (int rep_ = 0; rep_ < REP_ATTN_B; ++rep_) attn_phase(1, lds, a); }
            PHASE_END
            PHASE_BEGIN
                { EpiP e{X, nullptr, X, nullptr, DM, 0, 0, 0, 0, 0, 0, 0, nullptr, RS(4), HN}; run_gemm(EPI_RESID, lds, Ob, WB(W_B_O), M, DM, DM, e); }
                pconv_pass(in_ptr(1) + (size_t)1 * M * 256, PB, lane, gw, ngw);
            PHASE_END
        } else if (layer == 2) {
            PHASE_BEGIN_R(REP_QKV)
                { EpiP e{Qb, Kb, nullptr, nullptr, 0, 1024, 1024, 16, 64, 0, 0, 64, RS(6), nullptr, nullptr, LOG2E * 0.125f}; run_gemm(EPI_QK, lds, XBM, WB(W_C_QK), M, 2048, DM, e); }
                { EpiP e{Vb, nullptr, nullptr, nullptr, 0, 1024, 0, 16, 0, 0, 0, 64, RS(6), nullptr, nullptr}; run_gemm(EPI_VT, lds, WB(W_C_V), XBM, 1024, M, DM, e); }
            PHASE_END_R
            PHASE_BEGIN
                { AttnP a{Qb, Kb, Vb, Ob, nullptr, in_ptr(14), nullptr, nullptr, nullptr, nullptr, nullptr, nullptr, 0.f, 0}; for (int rep_ = 0; rep_ < REP_ATTN_C; ++rep_) attn_phase(2, lds, a); }
            PHASE_END
            PHASE_BEGIN
                { EpiP e{X, nullptr, X, nullptr, DM, 0, 0, 0, 0, 0, 0, 0, nullptr, RS(7), HN}; run_gemm(EPI_RESID, lds, Ob, WB(W_C_O), M, DM, DM, e); }
                pconv_pass(in_ptr(1) + (size_t)2 * M * 256, PB, lane, gw, ngw);
            PHASE_END
        } else {
            PHASE_BEGIN_R(REP_QKV)
                { EpiP e{Qb, Kb, nullptr, tabp, 0, 1024, 1024, 16, 64, 1, 0, 64, RS(9), nullptr, nullptr, LOG2E * 0.125f}; run_gemm(EPI_QK, lds, XBM, WB(W_D_QK), M, 2048, DM, e); }
                { EpiP e{Vb, nullptr, nullptr, nullptr, 0, 1024, 0, 8, 0, 0, 0, 128, RS(9), nullptr, nullptr}; run_gemm(EPI_VT, lds, WB(W_D_V), XBM, 1024, M, DM, e); }
            PHASE_END_R
            PHASE_BEGIN
                { const float li = 0.8f - 0.6f * 0.40656965974059917f;
                  AttnP a{Qb, Kb, Vb, Ob, nullptr, nullptr, in_ptr(18), in_ptr(19), in_ptr(20), in_ptr(21), in_ptr(22), (float*)HN, li, 0}; for (int rep_ = 0; rep_ < REP_ATTN_D; ++rep_) attn_phase(3, lds, a); }
            PHASE_END
            PHASE_BEGIN
                { EpiP e{X, nullptr, X, nullptr, DM, 0, 0, 0, 0, 0, 0, 0, nullptr, RS(10), HN}; run_gemm(EPI_RESID, lds, Ob, WB(W_D_O), M, DM, DM, e); }
                pconv_pass(in_ptr(1) + (size_t)3 * M * 256, PB, lane, gw, ngw);
            PHASE_END
        }
        const size_t wl = W_L + (size_t)layer * W_L_STRIDE;
        PHASE_BEGIN_R(REP_UP)
            { EpiP e{Hb, nullptr, nullptr, nullptr, FF, 0, 0, 0, 0, 0, 0, 0, RS(3 * layer + 1), nullptr, nullptr}; run_gemm(EPI_SQRELU, lds, HN, WB(wl + W_L_UP), M, FF, DM, e); }
            { EpiP e{Tb, nullptr, nullptr, nullptr, DM, 0, 0, 0, 0, 0, 0, 0, nullptr, nullptr, nullptr}; run_gemm(EPI_BF16, lds, PB, WB(wl + W_L_PROJ), M, DM, 256, e); }
        PHASE_END_R
        PHASE_BEGIN
            { EpiP e{X, nullptr, X, nullptr, DM, 0, 0, 0, 0, 0, 0, 0, nullptr, RS(3 * layer + 2), HN}; run_gemm(EPI_RESID, lds, Hb, WB(wl + W_L_DOWN), M, DM, FF, e); }
        PHASE_END
        PHASE_BEGIN
            { EpiP e{X, nullptr, Tb, nullptr, DM, 0, 0, 0, 0, 0, 0, 0, RS(3 * layer + 2), RS(3 * layer + 3), XBM}; run_gemm(EPI_GATE, lds, HN, WB(wl + W_L_GATE), M, DM, DM, e); }
        PHASE_END
    }
    PHASE_BEGIN
        final_norm_rs_pass(X, in_ptr(30), RS(12), lane, gw, ngw);
    PHASE_END
}
constexpr int N_PHASES = 1 + 4 + 5 + 3 + 3 + 4 * 3 + 1;

#ifndef MULTI_LAUNCH
#define MULTI_LAUNCH 0
#endif
extern "C" void kernel_launch(void* const* d_in, const int* in_sizes, int n_in, void* d_out, int out_size, void* d_ws, size_t ws_size, hipStream_t stream) {
    static int grid = 0;
    if (grid == 0) {
        if (n_in != 31 || ws_size < WS_END) { fprintf(stderr, "kernel_launch: unexpected inputs (n_in %d, ws %zu, need %zu)\n", n_in, ws_size, (size_t)WS_END); grid = -1; return; }
        int dev = 0, cus = 0, per_cu = 0;
        hipGetDevice(&dev); hipDeviceGetAttribute(&cus, hipDeviceAttributeMultiprocessorCount, dev);
        if (hipFuncSetAttribute((const void*)fwd_kernel, hipFuncAttributeMaxDynamicSharedMemorySize, LDS_BYTES) != hipSuccess) { fprintf(stderr, "kernel_launch: hipFuncSetAttribute failed\n"); grid = -1; return; }
        hipOccupancyMaxActiveBlocksPerMultiprocessor(&per_cu, (const void*)fwd_kernel, NTHREADS, LDS_BYTES);
        (void)hipGetLastError();
        if (per_cu < 1) per_cu = 1;
        grid = cus * 1;
        fprintf(stderr, "kernel_launch: cus %d per_cu %d grid %d\n", cus, per_cu, grid);
    }
    if (grid < 0) return;
    if (hipMemsetAsync(d_ws, 0, 16384, stream) != hipSuccess) { fprintf(stderr, "kernel_launch: memset of the barrier words failed\n"); return; }
    Args a{};
    for (int i = 0; i < 31; ++i) a.in[i] = (const float*)d_in[i];
    a.out = (float*)d_out; a.ws = (unsigned char*)d_ws;
#if MULTI_LAUNCH
    for (int p = 0; p < N_PHASES; ++p) { a.ph_lo = p; a.ph_hi = p + 1; hipLaunchKernelGGL(fwd_kernel, dim3(grid), dim3(NTHREADS), LDS_BYTES, stream, a); }
#else
    a.ph_lo = 0; a.ph_hi = N_PHASES;
    void* kargs[] = {&a};
    hipError_t e = hipLaunchCooperativeKernel((const void*)fwd_kernel, dim3(grid), dim3(NTHREADS), kargs, LDS_BYTES, stream);
    if (e != hipSuccess) fprintf(stderr, "cooperative launch failed: %s (grid %d)\n", hipGetErrorString(e), grid);
#endif
}
```

```cpp
#include <hip/hip_runtime.h>
#include <hip/hip_cooperative_groups.h>
#include <cstdio>
#include <cstdint>
namespace cg = cooperative_groups;

namespace pg8 {
#define PG8_LAS __attribute__((address_space(3)))
typedef unsigned short bf16_t;
typedef short bf16x8 __attribute__((ext_vector_type(8)));
typedef float f32x4 __attribute__((ext_vector_type(4)));
typedef unsigned u32x4 __attribute__((ext_vector_type(4)));
constexpr int BM = 256, BK = 64, HALF = 128, HTB = HALF * BK * 2  , STAGE_BYTES = 8 * HTB, NXCD = 8, WGM = 8;

__host__ __device__ __forceinline__ int lds_byte(int r, int c) { const int st = (r >> 4) * 2 + (c >> 5), rr = r & 15, cc = c & 31, ob = rr * 64 + cc * 2; return st * 1024 + (ob ^ (((ob >> 9) & 1) << 5)); }
__host__ __device__ __forceinline__ void stage_rc(int b, int& R, int& C) { const int st = b / 1024, sb = b % 1024, swz = sb ^ (((sb >> 9) & 1) << 5); R = (st >> 1) * 16 + swz / 64; C = (st & 1) * 32 + (swz % 64) / 2; }
__host__ __device__ __forceinline__ int perm32(int rho) { const int n = rho >> 4, i = rho & 15; return 8 * (i >> 2) + 4 * n + (i & 3); }

struct Unit { int pm, pn; };
struct Gemm { const bf16_t* A; const bf16_t* Bt; int M, N, K; };

struct StaticOrder {
    int nM, nN, nwg, G, c;
    __host__ __device__ void init(int M, int N, int G_, int c_) { nM = M / BM; nN = N / BM; nwg = nM * nN; G = G_; c = c_; }
    __host__ __device__ bool next(int i, Unit& u) const {
        const long L = (long)i * G + c; if (L >= nwg) return false;
        int wgid = (int)L; { const int q = nwg / NXCD, r = nwg % NXCD, xcd = wgid % NXCD, off = wgid / NXCD; wgid = (xcd < r ? xcd * (q + 1) : r * (q + 1) + (xcd - r) * q) + off; }
        const int nig = WGM * nN, gid = wgid / nig, fm = gid * WGM, gsz = (nM - fm) < WGM ? (nM - fm) : WGM;
        u.pm = fm + ((wgid % nig) % gsz); u.pn = (wgid % nig) / gsz; return true;
    }
    __device__ __forceinline__ void a_ready(const Unit&) const {}
    __device__ __forceinline__ void done(const Unit&) const {}
};

template <class Epi, class Sched, bool ALIGN_EPI = false, bool SP2 = false>
__device__ __forceinline__ void gemm_phase(PG8_LAS unsigned char* lds, const Gemm g, const Sched& S, const Epi& E, const int tid_in) {
    int tid_o = tid_in; asm volatile("" : "+v"(tid_o));
    const int tid = tid_o, wid = __builtin_amdgcn_readfirstlane(tid >> 6), lane = tid & 63, wr = wid >> 2, wc = wid & 3, fr = lane & 15, fq = lane >> 4;
    const int K = g.K, nt = K / BK;
    unsigned voffA[2], voffB[2];
#pragma unroll
    for (int i = 0; i < 2; ++i) { int R, C; stage_rc(tid * 16 + i * 8192, R, C); const int Rb = Epi::PERM ? ((R & ~31) + perm32(R & 31)) : R;
        voffA[i] = (unsigned)(R * K + C) * 2u; voffB[i] = (unsigned)(Rb * K + C) * 2u; }
    const size_t kstep = (size_t)(BK * 2);
    const size_t hstep = (size_t)HALF * K * 2;
    const size_t tstep = 2 * hstep;
    const unsigned ldsw = (unsigned)wid * 1024u;
    const int aoff = lds_byte(wr * 64 + fr, fq * 8), boff = lds_byte(wc * 32 + fr, fq * 8);
#define PG8_SA(b, h) (((b) * 2 + (h)) * HTB)
#define PG8_SB(b, h) ((4 + (b) * 2 + (h)) * HTB)
#define PG8_STAGE(bufoff, gbase, voff) do { _Pragma("unroll") for (int _i = 0; _i < 2; ++_i) \
        __builtin_amdgcn_global_load_lds((const unsigned*)((const char*)(gbase) + (voff)[_i]), (PG8_LAS unsigned*)(lds + (bufoff) + ldsw + _i * 8192), 16, 0, 0); } while (0)
#define PG8_LDA(dst, b, h) do { _Pragma("unroll") for (int m = 0; m < 4; ++m) _Pragma("unroll") for (int k = 0; k < 2; ++k) dst[m][k] = *(const PG8_LAS bf16x8*)(lds + PG8_SA(b, h) + aoff + m * 2048 + k * 1024); } while (0)
#define PG8_LDB(dst, b, h) do { _Pragma("unroll") for (int n = 0; n < 2; ++n) _Pragma("unroll") for (int k = 0; k < 2; ++k) dst[n][k] = *(const PG8_LAS bf16x8*)(lds + PG8_SB(b, h) + boff + n * 2048 + k * 1024); } while (0)
#define PG8_MMA(ai, bj, At, Bt) do { __builtin_amdgcn_s_setprio(1); _Pragma("unroll") for (int m = 0; m < 4; ++m) _Pragma("unroll") for (int n = 0; n < 2; ++n) _Pragma("unroll") for (int k = 0; k < 2; ++k) \
        acc[ai][bj][m][n] = __builtin_amdgcn_mfma_f32_16x16x32_bf16(Bt[n][k], At[m][k], acc[ai][bj][m][n], 0, 0, 0); __builtin_amdgcn_s_setprio(0); } while (0)
#define PG8_WAIT_V(n) asm volatile("s_waitcnt vmcnt(" #n ")" ::: "memory")
#define PG8_WAIT_L(n) asm volatile("s_waitcnt lgkmcnt(" #n ")" ::: "memory")
#define PG8_BAR __builtin_amdgcn_s_barrier()
#define PG8_SCHED __builtin_amdgcn_sched_barrier(0)
    Unit cur, nxt; int ui = 0;
    if (!S.next(0, cur)) return;
    f32x4 acc[2][2][4][2];
#pragma unroll
    for (int a = 0; a < 2; ++a)
#pragma unroll
        for (int b = 0; b < 2; ++b)
#pragma unroll
            for (int m = 0; m < 4; ++m)
#pragma unroll
                for (int n = 0; n < 2; ++n) acc[a][b][m][n] = (f32x4){0.f, 0.f, 0.f, 0.f};
    bf16x8 At[4][2], B0[2][2], B1[2][2];
    const char* cA = (const char*)g.A + (size_t)cur.pm * tstep; const char* cB = (const char*)g.Bt + (size_t)cur.pn * tstep;
    S.a_ready(cur);
    if constexpr (SP2) {
        PG8_STAGE(PG8_SB(0, 0), cB, voffB); PG8_STAGE(PG8_SB(0, 1), cB + hstep, voffB); PG8_STAGE(PG8_SA(0, 0), cA, voffA); PG8_STAGE(PG8_SA(0, 1), cA + hstep, voffA);
        if (wr == 1) PG8_BAR;
        PG8_WAIT_V(2); PG8_BAR;
        PG8_STAGE(PG8_SB(1, 0), cB + kstep, voffB); PG8_STAGE(PG8_SA(1, 0), cA + kstep, voffA); PG8_STAGE(PG8_SB(1, 1), cB + hstep + kstep, voffB);
        PG8_WAIT_V(6); PG8_BAR;
    } else {
        PG8_STAGE(PG8_SB(0, 0), cB, voffB); PG8_STAGE(PG8_SA(0, 0), cA, voffA); PG8_STAGE(PG8_SB(0, 1), cB + hstep, voffB); PG8_STAGE(PG8_SA(0, 1), cA + hstep, voffA);
        if (wr == 1) PG8_BAR;
        PG8_WAIT_V(4); PG8_BAR;
        PG8_STAGE(PG8_SB(1, 0), cB + kstep, voffB); PG8_STAGE(PG8_SA(1, 0), cA + kstep, voffA); PG8_STAGE(PG8_SB(1, 1), cB + hstep + kstep, voffB);
        PG8_WAIT_V(6); PG8_BAR;
    }
    for (;;) {
        const bool has_next = S.next(ui + 1, nxt);
        const char* nA = has_next ? (const char*)g.A + (size_t)nxt.pm * tstep : cA; const char* nB = has_next ? (const char*)g.Bt + (size_t)nxt.pn * tstep : cB;
        for (int t = 0; t < nt; t += 2) {
            const bool last = (t == nt - 2);
            const char* a1 = cA + (size_t)(t + 1) * kstep;
            const char* a2 = last ? nA : cA + (size_t)(t + 2) * kstep; const char* b2 = last ? nB : cB + (size_t)(t + 2) * kstep;
            const char* a3 = a2 + kstep; const char* b3 = b2 + kstep;
            if (last && has_next) S.a_ready(nxt);
            if constexpr (SP2) {
            PG8_LDB(B0, 0, 0); PG8_LDB(B1, 0, 1); PG8_SCHED; PG8_LDA(At, 0, 0); PG8_STAGE(PG8_SA(1, 1), a1 + hstep, voffA);
            PG8_WAIT_V(8); PG8_WAIT_L(0); PG8_BAR; PG8_MMA(0, 0, At, B0); PG8_MMA(0, 1, At, B1); PG8_BAR; PG8_SCHED;
            PG8_LDA(At, 0, 1); PG8_STAGE(PG8_SB(0, 0), b2, voffB); PG8_STAGE(PG8_SB(0, 1), b2 + hstep, voffB); PG8_STAGE(PG8_SA(0, 0), a2, voffA);
            PG8_WAIT_V(8); PG8_WAIT_L(0); PG8_BAR; PG8_MMA(1, 0, At, B0); PG8_MMA(1, 1, At, B1); PG8_BAR; PG8_SCHED;
            PG8_LDB(B0, 1, 0); PG8_LDB(B1, 1, 1); PG8_SCHED; PG8_LDA(At, 1, 0); PG8_STAGE(PG8_SA(0, 1), a2 + hstep, voffA);
            PG8_WAIT_V(8); PG8_WAIT_L(0); PG8_BAR; PG8_MMA(0, 0, At, B0); PG8_MMA(0, 1, At, B1); PG8_BAR; PG8_SCHED;
            PG8_LDA(At, 1, 1); PG8_STAGE(PG8_SB(1, 0), b3, voffB); PG8_STAGE(PG8_SB(1, 1), b3 + hstep, voffB); PG8_STAGE(PG8_SA(1, 0), a3, voffA);
            PG8_WAIT_V(8); PG8_WAIT_L(0); PG8_BAR; PG8_MMA(1, 0, At, B0); PG8_MMA(1, 1, At, B1); PG8_BAR; PG8_SCHED;
            } else {
            PG8_LDB(B0, 0, 0); PG8_SCHED; PG8_LDA(At, 0, 0); PG8_STAGE(PG8_SA(1, 1), a1 + hstep, voffA);
            PG8_WAIT_L(8); PG8_BAR; PG8_WAIT_L(0); PG8_MMA(0, 0, At, B0); PG8_BAR; PG8_SCHED;
            PG8_LDB(B1, 0, 1); PG8_STAGE(PG8_SB(0, 0), b2, voffB);
            PG8_BAR; PG8_WAIT_L(0); PG8_MMA(0, 1, At, B1); PG8_BAR;
            PG8_LDA(At, 0, 1); PG8_STAGE(PG8_SA(0, 0), a2, voffA);
            PG8_BAR; PG8_WAIT_L(0); PG8_MMA(1, 0, At, B0); PG8_BAR; PG8_SCHED;
            PG8_STAGE(PG8_SB(0, 1), b2 + hstep, voffB);
            PG8_WAIT_V(6); PG8_BAR; PG8_MMA(1, 1, At, B1); PG8_BAR;
            PG8_LDB(B0, 1, 0); PG8_SCHED; PG8_LDA(At, 1, 0); PG8_STAGE(PG8_SA(0, 1), a2 + hstep, voffA);
            PG8_WAIT_L(8); PG8_BAR; PG8_WAIT_L(0); PG8_MMA(0, 0, At, B0); PG8_BAR; PG8_SCHED;
            PG8_LDB(B1, 1, 1); PG8_STAGE(PG8_SB(1, 0), b3, voffB);
            PG8_BAR; PG8_WAIT_L(0); PG8_MMA(0, 1, At, B1); PG8_BAR;
            PG8_LDA(At, 1, 1); PG8_STAGE(PG8_SA(1, 0), a3, voffA);
            PG8_BAR; PG8_WAIT_L(0); PG8_MMA(1, 0, At, B0); PG8_BAR; PG8_SCHED;
            PG8_STAGE(PG8_SB(1, 1), b3 + hstep, voffB);
            PG8_WAIT_V(6); PG8_BAR; PG8_MMA(1, 1, At, B1); PG8_BAR;
            }
        }
        if constexpr (ALIGN_EPI) { if (wr == 0) PG8_BAR; }
        if constexpr (!Epi::AFTER_DRAIN) { E(acc, cur, wr, wc, fr, fq); S.done(cur); }
        if (!has_next) break;
#pragma unroll
        for (int a = 0; a < 2; ++a)
#pragma unroll
            for (int b = 0; b < 2; ++b)
#pragma unroll
                for (int m = 0; m < 4; ++m)
#pragma unroll
                    for (int n = 0; n < 2; ++n) acc[a][b][m][n] = (f32x4){0.f, 0.f, 0.f, 0.f};
        cur = nxt; cA = nA; cB = nB; ++ui;
        if constexpr (ALIGN_EPI) { if (wr == 1) PG8_BAR; }
    }
    PG8_WAIT_V(0);
    if constexpr (!ALIGN_EPI) { if (wr == 0) PG8_BAR; }
    PG8_BAR;
    if constexpr (Epi::AFTER_DRAIN) { E.fused(acc, cur, wr, wc, fr, fq, lds, wid, lane); S.done(cur); }
#undef PG8_SA
#undef PG8_SB
#undef PG8_STAGE
#undef PG8_LDA
#undef PG8_LDB
#undef PG8_MMA
#undef PG8_WAIT_V
#undef PG8_WAIT_L
#undef PG8_BAR
#undef PG8_SCHED
}
}

#define LAS __attribute__((address_space(3)))
typedef unsigned short bf16;
typedef short bf16x8 __attribute__((ext_vector_type(8)));
typedef short s16x4 __attribute__((ext_vector_type(4)));
typedef float f32x4 __attribute__((ext_vector_type(4)));
typedef float f32x16 __attribute__((ext_vector_type(16)));
typedef float f32x2_t __attribute__((ext_vector_type(2)));
typedef __bf16 bf16x2_t __attribute__((ext_vector_type(2)));
typedef unsigned u32x4 __attribute__((ext_vector_type(4)));
typedef unsigned u32x2 __attribute__((ext_vector_type(2)));

constexpr int M = 16384, DM = 1024, SEQ = 2048, NB = 8, FF = 4096;
constexpr float RMS_EPS = 1e-6f;
constexpr float LOG2E = 1.4426950408889634f;
constexpr int NWAVES = 8, NTHREADS = 512;
constexpr int LDS_BYTES = 147456;

__device__ __forceinline__ unsigned pk2(float lo, float hi) { f32x2_t v = {lo, hi}; return __builtin_bit_cast(unsigned, __builtin_convertvector(v, bf16x2_t)); }
__device__ __forceinline__ float bf2f(unsigned short b) { return __uint_as_float(((unsigned)b) << 16); }
__device__ __forceinline__ int lane_id_here() { int z = 0; asm volatile("" : "+v"(z)); return __builtin_amdgcn_mbcnt_hi(-1, __builtin_amdgcn_mbcnt_lo(-1, z)); }
__device__ __forceinline__ float shfl_idx(float v, int src) { return __int_as_float(__builtin_amdgcn_ds_bpermute(src << 2, __float_as_int(v))); }
__device__ __forceinline__ float shfl_xor_l(float v, int mask, int lane) { return shfl_idx(v, lane ^ mask); }
__device__ __forceinline__ float wave_sum(float v) {
    const int l = lane_id_here();
#pragma unroll
    for (int o = 1; o < 64; o <<= 1) v += shfl_xor_l(v, o, l);
    return v;
}

constexpr size_t MiB = 1u << 20;
constexpr size_t WS_TABP = 1 * MiB;
constexpr size_t WS_TABL = WS_TABP + 2048 * 16 * 4;
constexpr size_t WS_LSE = 2 * MiB;
constexpr size_t WS_W = 4 * MiB;
constexpr size_t W_A_QK = WS_W;
constexpr size_t W_A_V = W_A_QK + 4 * MiB;
constexpr size_t W_A_O = W_A_V + 2 * MiB;
constexpr size_t W_B_IN = W_A_O + 2 * MiB;
constexpr size_t W_B_UQ = W_B_IN + 1 * MiB;
constexpr size_t W_B_K = W_B_UQ + 768 * 1024;
constexpr size_t W_B_V = W_B_K + 256 * 1024;
constexpr size_t W_B_O = W_B_V + 256 * 1024;
constexpr size_t W_C_QK = W_B_O + 2 * MiB;
constexpr size_t W_C_V = W_C_QK + 4 * MiB;
constexpr size_t W_C_O = W_C_V + 2 * MiB;
constexpr size_t W_D_QK = W_C_O + 2 * MiB;
constexpr size_t W_D_V = W_D_QK + 4 * MiB;
constexpr size_t W_D_O = W_D_V + 2 * MiB;
constexpr size_t W_L = W_D_O + 2 * MiB;
constexpr size_t W_L_STRIDE = 8 * MiB + 8 * MiB + 2 * MiB + 512 * 1024;
constexpr size_t W_L_UP = 0, W_L_DOWN = 8 * MiB, W_L_GATE = 16 * MiB, W_L_PROJ = 18 * MiB;
constexpr size_t WS_PB = W_L + 4 * W_L_STRIDE;
constexpr size_t WS_HN = WS_PB + 8 * MiB;
constexpr size_t WS_BIG = WS_HN + 32 * MiB;
constexpr size_t BIG_Q = 0, BIG_K = 48 * MiB, BIG_V = 96 * MiB, BIG_O = 128 * MiB;
constexpr size_t WS_RS = WS_BIG + 160 * MiB;
constexpr size_t WS_END = WS_RS + 3 * MiB;

#define XB_TMO      128
#define XB_XCNT(j)  (256  + 64 * (j))
#define XB_XSUB(j)  (1280 + 64 * (j))
#define XB_XGEN(j)  (2304 + 64 * (j))
#define XB_TOP      3328
#define XB_TOPGEN   3392
#define XCD_BAR_WORDS 3456
#define XB_SPIN_CAP (1u << 18)

__device__ __forceinline__ unsigned xb_ld(unsigned* p)              { return __hip_atomic_load(p, __ATOMIC_RELAXED, __HIP_MEMORY_SCOPE_AGENT); }
__device__ __forceinline__ unsigned xb_add(unsigned* p, unsigned v) { return __hip_atomic_fetch_add(p, v, __ATOMIC_RELAXED, __HIP_MEMORY_SCOPE_AGENT); }
__device__ __forceinline__ unsigned xb_xcc_id() { return (unsigned)__builtin_amdgcn_s_getreg((3 << 11) | 20) & 0xFu; }
#define XB_SPIN(cond, bar) do { unsigned _sp = 0; while (cond) { __builtin_amdgcn_s_sleep(1); \
    if ((++_sp & 255u) == 0u) { if (xb_ld(&(bar)[XB_TMO])) break; if (_sp > XB_SPIN_CAP) { atomicAdd(&(bar)[XB_TMO], 1u); break; } } } } while (0)

struct XcdBarrier {
    unsigned* bar; unsigned x;
    volatile LAS unsigned* st;
};

__device__ __forceinline__ XcdBarrier xcd_barrier_post(unsigned* bar, volatile LAS unsigned* st, bool is_t0) {
    XcdBarrier b; b.bar = bar; b.x = xb_xcc_id(); b.st = st;
    if (is_t0) (void)xb_add(&bar[XB_XCNT(b.x)], 1u);
    return b;
}
__device__ __forceinline__ void xcd_barrier_complete(unsigned* bar, unsigned x, unsigned& nloc, unsigned& nx) {
    const unsigned G = gridDim.x * gridDim.y * gridDim.z;
    unsigned sum, cnt, mine, sp = 0u;
    for (;;) {
        sum = 0u; cnt = 0u; mine = 0u;
#pragma unroll
        for (unsigned j = 0; j < 16; ++j) { const unsigned c = xb_ld(&bar[XB_XCNT(j)]); sum += c; cnt += (c > 0u) ? 1u : 0u; mine = (j == x) ? c : mine; }
        if (sum == G) break;
        __builtin_amdgcn_s_sleep(1);
        if ((++sp & 255u) == 0u) { if (xb_ld(&bar[XB_TMO])) break; if (sp > XB_SPIN_CAP) { atomicAdd(&bar[XB_TMO], 1u); break; } }
    }
    nloc = mine > 0u ? mine : 1u; nx = cnt > 0u ? cnt : 1u;
}

__device__ __forceinline__ void xcd_barrier(const XcdBarrier& b, bool is_t0) {
    asm volatile("s_waitcnt vmcnt(0)" ::: "memory");
    __syncthreads();
    if (is_t0) {
        unsigned* bar = b.bar;
        __builtin_amdgcn_s_waitcnt(0);
        unsigned nloc = b.st[0], nx = b.st[1];
        if (nloc == 0u) { xcd_barrier_complete(bar, b.x, nloc, nx); b.st[0] = nloc; b.st[1] = nx; }
        const unsigned old = xb_add(&bar[XB_XSUB(b.x)], 1u);
        const unsigned gen = old / nloc;
        if (old + 1u == (gen + 1u) * nloc) {
            __builtin_amdgcn_fence(__ATOMIC_RELEASE, "agent");
            asm volatile("s_waitcnt vmcnt(0)" ::: "memory");
            const unsigned og = xb_add(&bar[XB_TOP], 1u);
            const unsigned tg = og / nx;
            if (og + 1u == (tg + 1u) * nx) xb_add(&bar[XB_TOPGEN], 1u);
            else XB_SPIN(xb_ld(&bar[XB_TOPGEN]) == tg, bar);
            __builtin_amdgcn_fence(__ATOMIC_ACQUIRE, "agent");
            xb_add(&bar[XB_XGEN(b.x)], 1u);
            asm volatile("s_waitcnt vmcnt(0)" ::: "memory");
        } else {
            XB_SPIN(xb_ld(&bar[XB_XGEN(b.x)]) == gen, bar);
            __builtin_amdgcn_fence(__ATOMIC_ACQUIRE, "agent");
            asm volatile("s_waitcnt vmcnt(0)" ::: "memory");
        }
    }
    __syncthreads();
}

enum { EPI_QK = 0, EPI_VT, EPI_RESID, EPI_SQRELU, EPI_BF16, EPI_GATE, EPI_F32, EPI_MLAQ };
struct EpiP {
    void* o0; void* o1; const void* aux; const float* tab;
    int ld, qcols, kcols, heads, hstride, rope, dil, dv;
    const float* rs_in;
    float* rs_out;
    bf16* xb_out;
    float qscale;
};
__device__ __forceinline__ int dil_of_head(int head) { return head < 5 ? 1 : (head < 10 ? 4 : 16); }
__device__ __forceinline__ int perm_pos(int s, int dil) { return (s % dil) * (SEQ / dil) + s / dil; }

__device__ __forceinline__ float rowsum16(const float* r) {
    const f32x4 a = *(const f32x4*)r, b = *(const f32x4*)(r + 4), c = *(const f32x4*)(r + 8), d = *(const f32x4*)(r + 12);
    return (((a[0] + a[1]) + (a[2] + a[3])) + ((b[0] + b[1]) + (b[2] + b[3]))) + (((c[0] + c[1]) + (c[2] + c[3])) + ((d[0] + d[1]) + (d[2] + d[3])));
}
template <int MODE> struct Epi {
    static constexpr bool PERM = true, AFTER_DRAIN = false;
    EpiP p;
    struct Pre { f32x4 rs[4]; f32x4 xa[2][2]; u32x4 tw[2]; u32x4 xw[2]; f32x4 tb[4]; };
    __device__ __forceinline__ void prefetch(Pre& q, const pg8::Unit& u, int wr, int wc, int fr, int fq, int ai, int m) const {
        const int row = u.pm * 256 + ai * 128 + wr * 64 + m * 16 + fr;
        if (MODE != EPI_VT && p.rs_in) { const float* r = p.rs_in + (size_t)row * 16;
#pragma unroll
            for (int j = 0; j < 4; ++j) q.rs[j] = *(const f32x4*)(r + 4 * j); }
        if constexpr (MODE == EPI_RESID || MODE == EPI_GATE) {
#pragma unroll
            for (int bj = 0; bj < 2; ++bj) {
                const int col0 = u.pn * 256 + bj * 128 + wc * 32 + 8 * fq;
                if constexpr (MODE == EPI_RESID) {
                    if (p.rope) { const float* bp = (const float*)p.aux + (size_t)row * p.ld + col0; q.xa[bj][0] = *(const f32x4*)bp; q.xa[bj][1] = *(const f32x4*)(bp + 4); }
                    else q.xw[bj] = *(const u32x4*)((const bf16*)p.aux + (size_t)row * p.ld + col0);
                } else {
                    q.xw[bj] = *(const u32x4*)((const bf16*)p.o1 + (size_t)row * p.ld + col0);
                    q.tw[bj] = *(const u32x4*)((const bf16*)p.aux + (size_t)row * p.ld + col0);
                }
            }
        }
        if constexpr (MODE == EPI_QK) { if (p.rope) { const float* t = p.tab + (row & 2047) * 16;
#pragma unroll
            for (int j = 0; j < 4; ++j) q.tb[j] = *(const f32x4*)(t + 4 * j); } }
    }
    __device__ __forceinline__ void operator()(const pg8::f32x4 (&acc)[2][2][4][2], const pg8::Unit& u, int wr, int wc, int fr_in, int fq_in) const {
        const int l_ = lane_id_here(), fr = l_ & 15, fq = l_ >> 4;
        (void)fr_in; (void)fq_in;
        float rst_tok = 1.f;
        if (MODE == EPI_VT && p.rs_in) rst_tok = rsqrtf(rowsum16(p.rs_in + (size_t)(u.pn * 256 + 128 * (l_ >> 5) + 32 * wc + (l_ & 31)) * 16) * (1.f / DM) + RMS_EPS);
        Pre q0; prefetch(q0, u, wr, wc, fr, fq, 0, 0);
#pragma unroll
        for (int step = 0; step < 8; ++step) {
            const int ai = step >> 2, m = step & 3;
            Pre q1; if (step < 7) prefetch(q1, u, wr, wc, fr, fq, (step + 1) >> 2, (step + 1) & 3);
            {
                const int row = u.pm * 256 + ai * 128 + wr * 64 + m * 16 + fr;
                float rstd = 1.f;
                if (MODE != EPI_VT && p.rs_in) { const f32x4 a = q0.rs[0], b = q0.rs[1], c = q0.rs[2], d = q0.rs[3];
                    rstd = rsqrtf(((((a[0] + a[1]) + (a[2] + a[3])) + ((b[0] + b[1]) + (b[2] + b[3]))) + (((c[0] + c[1]) + (c[2] + c[3])) + ((d[0] + d[1]) + (d[2] + d[3])))) * (1.f / DM) + RMS_EPS); }
                float ss = 0.f;
#pragma unroll
                for (int bj = 0; bj < 2; ++bj) {
                    const int col0 = u.pn * 256 + bj * 128 + wc * 32 + 8 * fq;
                    float v[8];
#pragma unroll
                    for (int j = 0; j < 4; ++j) { v[j] = acc[ai][bj][m][0][j] * rstd; v[4 + j] = acc[ai][bj][m][1][j] * rstd; }
                    if (MODE == EPI_VT && p.rs_in) {
#pragma unroll
                        for (int j = 0; j < 8; ++j) v[j] *= shfl_idx(rst_tok, bj * 32 + 8 * fq + j);
                    }
                    if constexpr (MODE == EPI_QK) {
                        const int b = row >> 11, s = row & 2047;
                        if (col0 < p.qcols) {
#pragma unroll
                            for (int j = 0; j < 8; ++j) v[j] *= p.qscale;
                        }
                        if (p.rope) {
                            float pr[8];
                            { const int ll = l_ ^ 16;
#pragma unroll
                            for (int j = 0; j < 8; ++j) pr[j] = shfl_idx(v[j], ll); }
                            const int d0 = col0 & 63;
                            if (d0 < 16) {
                                const f32x4 c0 = q0.tb[0], c1 = q0.tb[1], s0 = q0.tb[2], s1 = q0.tb[3];
                                const float sg = (d0 == 0) ? -1.f : 1.f;
#pragma unroll
                                for (int j = 0; j < 4; ++j) { v[j] = v[j] * c0[j] + sg * pr[j] * s0[j]; v[4 + j] = v[4 + j] * c1[j] + sg * pr[4 + j] * s1[j]; }
                            }
                        }
                        if (col0 < p.qcols + p.kcols) {
                            const bool isk = col0 >= p.qcols; const int cc = isk ? col0 - p.qcols : col0;
                            const int head = cc >> 6, d0 = cc & 63;
                            int pos = s; if (p.dil) pos = perm_pos(s, dil_of_head(head));
                            bf16* dst = (bf16*)(isk ? p.o1 : p.o0) + ((size_t)(b * p.heads + head) * SEQ + pos) * p.hstride + d0;
                            u32x4 w; w.x = pk2(v[0], v[1]); w.y = pk2(v[2], v[3]); w.z = pk2(v[4], v[5]); w.w = pk2(v[6], v[7]);
                            *(u32x4*)dst = w;
                        }
                    } else if constexpr (MODE == EPI_MLAQ) {
                        const int b = row >> 11, s = row & 2047;
#pragma unroll
                        for (int j = 0; j < 8; ++j) v[j] *= p.qscale;
                        float pr[8];
                        { const int ll = l_ ^ 32;
#pragma unroll
                        for (int j = 0; j < 8; ++j) pr[j] = shfl_idx(v[j], ll); }
                        if (col0 < 1536) {
                            const int head = col0 / 96, w0 = col0 - head * 96;
                            if (w0 >= 64) {
                                const int jj = w0 - 64; const float* t = p.tab + s * 32;
                                const int jb = jj & 15; const float sg = (jj < 16) ? -1.f : 1.f;
                                const f32x4 c0 = *(const f32x4*)(t + jb), c1 = *(const f32x4*)(t + jb + 4), s0 = *(const f32x4*)(t + 16 + jb), s1 = *(const f32x4*)(t + 16 + jb + 4);
#pragma unroll
                                for (int j = 0; j < 4; ++j) { v[j] = v[j] * c0[j] + sg * pr[j] * s0[j]; v[4 + j] = v[4 + j] * c1[j] + sg * pr[4 + j] * s1[j]; }
                            }
                            bf16* dst = (bf16*)p.o0 + ((size_t)(b * 16 + head) * SEQ + s) * 96 + w0;
                            u32x4 w; w.x = pk2(v[0], v[1]); w.y = pk2(v[2], v[3]); w.z = pk2(v[4], v[5]); w.w = pk2(v[6], v[7]);
                            *(u32x4*)dst = w;
                        }
                    } else if constexpr (MODE == EPI_VT) {
                        if (row < p.qcols) {
                            const int head = row / p.dv, d = row - head * p.dv;
                            const int b = col0 >> 11, s0 = col0 & 2047;
                            bf16* base = (bf16*)p.o0 + (size_t)(b * p.heads + head) * p.dv * SEQ + (size_t)d * 64;
                            const int dil = p.dil ? dil_of_head(head) : 1;
                            if (dil == 1) {
                                u32x4 w; w.x = pk2(v[0], v[1]); w.y = pk2(v[2], v[3]); w.z = pk2(v[4], v[5]); w.w = pk2(v[6], v[7]);
                                *(u32x4*)(base + (size_t)(s0 >> 6) * (p.dv * 64) + (s0 & 63)) = w;
                            } else {
#pragma unroll
                                for (int j = 0; j < 8; ++j) { const int pp = perm_pos(s0 + j, dil); base[(size_t)(pp >> 6) * (p.dv * 64) + (pp & 63)] = (bf16)(pk2(v[j], 0.f) & 0xffffu); }
                            }
                        }
                    } else if constexpr (MODE == EPI_RESID) {
                        if (p.rope) { const f32x4 b0 = q0.xa[bj][0], b1 = q0.xa[bj][1];
#pragma unroll
                            for (int j = 0; j < 4; ++j) { v[j] += b0[j]; v[4 + j] += b1[j]; }
                        } else { const u32x4 xw = q0.xw[bj];
                            v[0] += __uint_as_float(xw.x << 16); v[1] += __uint_as_float(xw.x & 0xffff0000u); v[2] += __uint_as_float(xw.y << 16); v[3] += __uint_as_float(xw.y & 0xffff0000u);
                            v[4] += __uint_as_float(xw.z << 16); v[5] += __uint_as_float(xw.z & 0xffff0000u); v[6] += __uint_as_float(xw.w << 16); v[7] += __uint_as_float(xw.w & 0xffff0000u); }
                        if (p.xb_out) {
                            u32x4 w; w.x = pk2(v[0], v[1]); w.y = pk2(v[2], v[3]); w.z = pk2(v[4], v[5]); w.w = pk2(v[6], v[7]);
                            *(u32x4*)(p.xb_out + (size_t)row * p.ld + col0) = w;
#pragma unroll
                            for (int j = 0; j < 8; ++j) ss += v[j] * v[j];
                        }
                    } else if constexpr (MODE == EPI_SQRELU) {
#pragma unroll
                        for (int j = 0; j < 8; ++j) { const float r = fmaxf(v[j], 0.f); v[j] = r * r; }
                        u32x4 w; w.x = pk2(v[0], v[1]); w.y = pk2(v[2], v[3]); w.z = pk2(v[4], v[5]); w.w = pk2(v[6], v[7]);
                        *(u32x4*)((bf16*)p.o0 + (size_t)row * p.ld + col0) = w;
                    } else if constexpr (MODE == EPI_BF16) {
                        u32x4 w; w.x = pk2(v[0], v[1]); w.y = pk2(v[2], v[3]); w.z = pk2(v[4], v[5]); w.w = pk2(v[6], v[7]);
                        *(u32x4*)((bf16*)p.o0 + (size_t)row * p.ld + col0) = w;
                    } else if constexpr (MODE == EPI_GATE) {
                        const u32x4 tw = q0.tw[bj], xw = q0.xw[bj];
                        float t[8];
                        t[0] = __uint_as_float(tw.x << 16); t[1] = __uint_as_float(tw.x & 0xffff0000u); t[2] = __uint_as_float(tw.y << 16); t[3] = __uint_as_float(tw.y & 0xffff0000u);
                        t[4] = __uint_as_float(tw.z << 16); t[5] = __uint_as_float(tw.z & 0xffff0000u); t[6] = __uint_as_float(tw.w << 16); t[7] = __uint_as_float(tw.w & 0xffff0000u);
                        f32x4 x0 = {__uint_as_float(xw.x << 16), __uint_as_float(xw.x & 0xffff0000u), __uint_as_float(xw.y << 16), __uint_as_float(xw.y & 0xffff0000u)};
                        f32x4 x1 = {__uint_as_float(xw.z << 16), __uint_as_float(xw.z & 0xffff0000u), __uint_as_float(xw.w << 16), __uint_as_float(xw.w & 0xffff0000u)};
#pragma unroll
                        for (int j = 0; j < 4; ++j) { x0[j] += t[j] / (1.f + __expf(-v[j])); x1[j] += t[4 + j] / (1.f + __expf(-v[4 + j])); }
                        if (p.xb_out) {
                            u32x4 w; w.x = pk2(x0[0], x0[1]); w.y = pk2(x0[2], x0[3]); w.z = pk2(x1[0], x1[1]); w.w = pk2(x1[2], x1[3]);
                            *(u32x4*)(p.xb_out + (size_t)row * p.ld + col0) = w;
#pragma unroll
                            for (int j = 0; j < 4; ++j) ss += x0[j] * x0[j] + x1[j] * x1[j];
                        }
                    } else if constexpr (MODE == EPI_F32) {
                        float* op = (float*)p.o0 + (size_t)row * p.ld + col0;
                        *(f32x4*)op = (f32x4){v[0], v[1], v[2], v[3]}; *(f32x4*)(op + 4) = (f32x4){v[4], v[5], v[6], v[7]};
                    }
                }
                if ((MODE == EPI_RESID || MODE == EPI_GATE) && p.rs_out) {
                    ss += shfl_idx(ss, l_ ^ 16); ss += shfl_idx(ss, l_ ^ 32);
                    if (fq == 0) p.rs_out[(size_t)row * 16 + u.pn * 4 + wc] = ss;
                }
            }
            asm volatile("" ::: "memory");
            q0 = q1;
        }
    }
};

template <int MODE>
__device__ __forceinline__ void run_gemm_(LAS unsigned char* lds, const bf16* A, const bf16* Bt, int Mr, int Nc, int K, const EpiP& ep, int wave_s) {
    const int tid = wave_s * 64 + lane_id_here();
    int bx = blockIdx.x, gx = gridDim.x; asm volatile("" : "+s"(bx), "+s"(gx));
    pg8::Gemm g{A, Bt, Mr, Nc, K}; pg8::StaticOrder S; S.init(Mr, Nc, gx, bx);
    Epi<MODE> E{ep};
    pg8::gemm_phase<Epi<MODE>, pg8::StaticOrder, true, true>(lds, g, S, E, tid);
}


struct AttnP {
    const bf16* Q; const bf16* K; const bf16* Vt; bf16* O; float* lse;
    const float* rpb; const float* lq1; const float* lk1; const float* lq2; const float* lk2; const float* subln;
    float* stash; float lambda_init; int pad;
};
#define GAS __attribute__((address_space(1)))
__device__ __forceinline__ float vmax3(float a, float b, float c) { float r; asm("v_max3_f32 %0, %1, %2, %3" : "=v"(r) : "v"(a), "v"(b), "v"(c)); return r; }
__device__ __forceinline__ float vmax16(float m, const f32x16& s) {
    asm("v_max3_f32 %0, %1, %2, %0\n\tv_max3_f32 %0, %3, %4, %0\n\tv_max3_f32 %0, %5, %6, %0\n\tv_max3_f32 %0, %7, %8, %0\n\t"
        "v_max3_f32 %0, %9, %10, %0\n\tv_max3_f32 %0, %11, %12, %0\n\tv_max3_f32 %0, %13, %14, %0\n\tv_max3_f32 %0, %15, %16, %0"
        : "+v"(m) : "v"(s[0]), "v"(s[1]), "v"(s[2]), "v"(s[3]), "v"(s[4]), "v"(s[5]), "v"(s[6]), "v"(s[7]), "v"(s[8]), "v"(s[9]), "v"(s[10]), "v"(s[11]), "v"(s[12]), "v"(s[13]), "v"(s[14]), "v"(s[15]));
    return m;
}
__device__ __forceinline__ float halfmax3(float m_other, float x) {
    const auto r = __builtin_amdgcn_permlane32_swap(__float_as_uint(x), __float_as_uint(x), false, false);
    return vmax3(m_other, __uint_as_float(r[0]), __uint_as_float(r[1]));
}
#define MFMA32(a, b, c) __builtin_amdgcn_mfma_f32_32x32x16_bf16((a), (b), (c), 0, 0, 0)

template <int MODE>
__device__ __forceinline__ void attn_phase_(LAS unsigned char* lds, const AttnP& P, const int tid_in) {
    constexpr int DQ = (MODE == 1) ? 96 : 64, DV = (MODE == 3) ? 128 : 64;
    constexpr int H = (MODE == 0) ? 15 : (MODE == 3 ? 8 : 16);
    constexpr int HQ = (MODE == 3) ? 16 : H;
    constexpr int NPASS = (MODE == 3) ? 2 : 1;
    constexpr int KROW = DQ * 2 + 16, VROW = 136;
    constexpr int NKS = DQ / 16, NDB = DV / 32;
    constexpr int KCH = 64 * (DQ / 8);
    constexpr int VCH = DV * 8;
    constexpr int NU = NB * H * 8;
    constexpr int KBUF = 64 * KROW, VBUF = DV * VROW;
    constexpr int K_OFF = 0, V_OFF = 2 * 13312, B_OFF = V_OFF + 2 * 17408;
    static_assert(KBUF <= 13312 && VBUF <= 17408, "attention LDS map");
    int tid_o = tid_in; asm volatile("" : "+v"(tid_o));
    const int tid = tid_o, lane = tid & 63, wave = __builtin_amdgcn_readfirstlane(tid >> 6), r32 = lane & 31, h = lane >> 5;
    LAS float* ldsB = (LAS float*)(lds + B_OFF);

    float lam = 0.f;
    if constexpr (MODE == 3) {
        const float a1 = wave_sum(P.lq1[lane] * P.lk1[lane]), a2 = wave_sum(P.lq2[lane] * P.lk2[lane]);
        lam = __expf(a1) - __expf(a2) + P.lambda_init;
    }

    int bx = blockIdx.x, gx = gridDim.x; asm volatile("" : "+s"(bx), "+s"(gx));
    const bool xmap = (gx & 7) == 0; const int xcd = bx & 7, nslot = gx >> 3;
    for (int it = xmap ? (bx >> 3) : bx; ; it += xmap ? nslot : gx) {
        int unit;
        if (xmap) { const int bh_ = (it >> 3) * 8 + xcd; if (bh_ >= NB * H) break; unit = bh_ * 8 + (it & 7); } else { if (it >= NU) break; unit = it; }
        const int qb = unit & 7, bh = unit >> 3, head = bh % H, b = bh / H;
        int kt_lo = 0, kt_hi = 32;
        if constexpr (MODE == 0) { kt_lo = max(0, qb * 4 - 1); kt_hi = min(32, qb * 4 + 5); }
        if constexpr (MODE == 2) { const int r0 = qb * 4; kt_lo = min(max(r0 - 4, 0), 24); kt_hi = min(max(r0 - 1, 0), 24) + 8; }
        const int wq0 = qb * 256 + wave * 32, qpos = wq0 + r32;
        int dil = 1, L = SEQ;
        if constexpr (MODE == 0) { dil = dil_of_head(head); L = SEQ / dil; }
        int qr = 0, qc = 0, rs = 0, win0 = 0;
        if constexpr (MODE == 2) { qr = qpos >> 6; qc = qpos & 63; rs = min(max(qr - 4, 0), 24); win0 = min(max(qc - 8, 0), 48); }
        if constexpr (MODE == 2) {
            __syncthreads();
            for (int i = tid; i < 15 * 31; i += NTHREADS) ldsB[i] = P.rpb[head * 465 + i] * LOG2E;
        }
#pragma nounroll
        for (int pass = 0; pass < NPASS; ++pass) {
            const int hq = (MODE == 3) ? 2 * head + pass : head;
            const bf16* Qp = P.Q + (size_t)(b * HQ + hq) * SEQ * DQ;
            const bf16* Kp = P.K + (size_t)(b * HQ + hq) * SEQ * DQ;
            const bf16* Vp = P.Vt + (size_t)(b * H + head) * DV * SEQ;
            bf16x8 qf[NKS];
#pragma unroll
            for (int ks = 0; ks < NKS; ++ks) qf[ks] = *(const GAS bf16x8*)(Qp + (size_t)qpos * DQ + ks * 16 + h * 8);
            f32x16 O[NDB];
#pragma unroll
            for (int db = 0; db < NDB; ++db)
#pragma unroll
                for (int i = 0; i < 16; ++i) O[db][i] = 0.f;
            float mrun = -1e30f, lsum = 0.f;
            u32x4 kreg0, kreg1, vreg0, vreg1;
            const int kc0 = tid, kc1 = tid + 512;
            const int kr0 = kc0 / (DQ / 8), kcc0 = kc0 % (DQ / 8), kr1 = kc1 / (DQ / 8), kcc1 = kc1 % (DQ / 8);
            const int vd0 = tid >> 3, vcc = tid & 7, vd1 = vd0 + 64;
#define GLOAD_K(kt_) do { const bf16* kb = Kp + (size_t)(kt_) * 64 * DQ; \
                kreg0 = *(const GAS u32x4*)(kb + kr0 * DQ + kcc0 * 8); \
                if (KCH > 512 && kc1 < KCH) kreg1 = *(const GAS u32x4*)(kb + kr1 * DQ + kcc1 * 8); } while (0)
#define GLOAD_V(kt_) do { const bf16* vb = Vp + (size_t)(kt_) * (DV * 64);     \
                vreg0 = *(const GAS u32x4*)(vb + vd0 * 64 + vcc * 8); \
                if (VCH > 512) vreg1 = *(const GAS u32x4*)(vb + vd1 * 64 + vcc * 8); } while (0)
#define LSTORE_K(buf_) do { LAS unsigned char* kB = lds + K_OFF + (buf_) * 13312; \
                *(LAS u32x4*)(kB + kr0 * KROW + kcc0 * 16) = kreg0; \
                if (KCH > 512 && kc1 < KCH) *(LAS u32x4*)(kB + kr1 * KROW + kcc1 * 16) = kreg1; } while (0)
#define LSTORE_V(buf_) do { LAS unsigned char* vB = lds + V_OFF + (buf_) * 17408; \
                { LAS unsigned char* vp = vB + vd0 * VROW + vcc * 16; *(LAS u32x2*)vp = (u32x2){vreg0.x, vreg0.y}; *(LAS u32x2*)(vp + 8) = (u32x2){vreg0.z, vreg0.w}; } \
                if (VCH > 512) { LAS unsigned char* vp = vB + vd1 * VROW + vcc * 16; *(LAS u32x2*)vp = (u32x2){vreg1.x, vreg1.y}; *(LAS u32x2*)(vp + 8) = (u32x2){vreg1.z, vreg1.w}; } } while (0)
#define QK_TILE(S0_, S1_, kb_) do { const LAS unsigned char* ldsK = lds + K_OFF + (kb_) * 13312; \
                _Pragma("unroll") for (int i = 0; i < 16; ++i) { S0_[i] = 0.f; S1_[i] = 0.f; } \
                _Pragma("unroll") for (int ks = 0; ks < NKS; ++ks) { \
                    const bf16x8 a0 = *(const LAS bf16x8*)(ldsK + r32 * KROW + ks * 32 + h * 16); \
                    const bf16x8 a1 = *(const LAS bf16x8*)(ldsK + (32 + r32) * KROW + ks * 32 + h * 16); \
                    S0_ = MFMA32(a0, qf[ks], S0_); S1_ = MFMA32(a1, qf[ks], S1_); } } while (0)
#define TILE_SKIP(kt_) ((MODE == 0) ? (((kt_) * 64 > wq0 + 95) || ((kt_) * 64 + 63 < wq0 - 64) || (((kt_) * 64) / L != wq0 / L)) : \
                        (MODE == 2) ? (((kt_) < rs_u) || ((kt_) >= rs_u + 8)) : false)
            const int rs_u = (MODE == 2) ? __builtin_amdgcn_readfirstlane(rs) : 0;
            GLOAD_K(kt_lo); GLOAD_V(kt_lo);
            __syncthreads();
            LSTORE_K(0); LSTORE_V(0);
            if (kt_lo + 1 < kt_hi) GLOAD_K(kt_lo + 1);
            __syncthreads();
            f32x16 s0, s1;
#pragma unroll
            for (int i = 0; i < 16; ++i) { s0[i] = 0.f; s1[i] = 0.f; }
            if (!TILE_SKIP(kt_lo)) QK_TILE(s0, s1, 0);
            if (kt_lo + 1 < kt_hi) { LSTORE_K(1); GLOAD_V(kt_lo + 1); if (kt_lo + 2 < kt_hi) GLOAD_K(kt_lo + 2); }
            __syncthreads();
            for (int kt = kt_lo; kt < kt_hi; ++kt) {
                const int j = kt - kt_lo;
                const LAS unsigned char* ldsV = lds + V_OFF + (j & 1) * 17408;
                const LAS unsigned char* ldsKn = lds + K_OFF + ((j + 1) & 1) * 13312;
                const int key0 = kt * 64;
                constexpr bool DENSE = (MODE == 1 || MODE == 3);
                const bool do_cur = DENSE ? true : !TILE_SKIP(kt), do_nxt = DENSE ? true : ((kt + 1 < kt_hi) && !TILE_SKIP(kt + 1));
                constexpr int KPRE = (MODE == 1) ? NKS : ((MODE == 3) ? 0 : 2), VPRE = (NDB > 2) ? 1 : 2;
                bf16x8 kf[KPRE > 0 ? KPRE : 1][2]; u32x4 vf[VPRE > 0 ? VPRE : 1][NDB];
#define KFRAG(ks_, hf_) (*(const LAS bf16x8*)(ldsKn + ((hf_) * 32 + r32) * KROW + (ks_) * 32 + h * 16))
                if (do_nxt) {
#pragma unroll
                    for (int ks = 0; ks < KPRE; ++ks) { kf[ks][0] = KFRAG(ks, 0); kf[ks][1] = KFRAG(ks, 1); }
                }
#define VFRAG(c_, db_) ({ const LAS unsigned char* vp_ = ldsV + ((db_) * 32 + r32) * VROW + ((c_) * 16 + 4 * h) * 2; \
                          const u32x2 lo_ = *(const LAS u32x2*)vp_, hi_ = *(const LAS u32x2*)(vp_ + 16); (u32x4){lo_.x, lo_.y, hi_.x, hi_.y}; })
                if (do_cur) {
#pragma unroll
                    for (int c = 0; c < VPRE; ++c)
#pragma unroll
                        for (int db = 0; db < NDB; ++db) vf[c][db] = VFRAG(c, db);
                }
                __builtin_amdgcn_sched_barrier(0);
                u32x4 pw[4];
                if (do_cur) {
                    float mx = -INFINITY;
#pragma unroll
                    for (int i = 0; i < 16; ++i) {
                        float v0 = s0[i], v1 = s1[i];
                        if constexpr (MODE == 0) {
                            const int kl = (i & 3) + 8 * (i >> 2) + 4 * h;
                            const int d0 = qpos - (key0 + kl), d1 = d0 - 32;
                            if (d0 > 64 || d0 < -64) v0 = -INFINITY;
                            if (d1 > 64 || d1 < -64) v1 = -INFINITY;
                        }
                        if constexpr (MODE == 2) {
                            const int kl = (i & 3) + 8 * (i >> 2) + 4 * h;
                            const int c0 = kl, c1 = kl + 32; const int rb = (kt - qr + 7) * 31 + 15 - qc;
                            v0 = (c0 >= win0 && c0 < win0 + 16) ? v0 + ldsB[rb + c0] : -INFINITY;
                            v1 = (c1 >= win0 && c1 < win0 + 16) ? v1 + ldsB[rb + c1] : -INFINITY;
                        }
                        s0[i] = v0; s1[i] = v1;
                    }
                    mx = vmax16(vmax16(mx, s0), s1);
                    const float mnew = halfmax3(mrun, mx);
                    if (__builtin_amdgcn_ballot_w64(mnew > mrun + 8.f) != 0ull) {
                        const float alpha = __builtin_amdgcn_exp2f(mrun - mnew);
                        lsum *= alpha;
#pragma unroll
                        for (int db = 0; db < NDB; ++db)
#pragma unroll
                            for (int i = 0; i < 16; ++i) O[db][i] *= alpha;
                        mrun = mnew;
                    }
                }
                f32x16 n0, n1;
#pragma unroll
                for (int i = 0; i < 16; ++i) { n0[i] = 0.f; n1[i] = 0.f; }
                if (do_nxt) {
#pragma unroll
                    for (int ks = 0; ks < KPRE; ++ks) { n0 = MFMA32(kf[ks][0], qf[ks], n0); n1 = MFMA32(kf[ks][1], qf[ks], n1); }
#pragma unroll
                    for (int ks = KPRE; ks < NKS; ++ks) { const bf16x8 a0 = KFRAG(ks, 0), a1 = KFRAG(ks, 1); n0 = MFMA32(a0, qf[ks], n0); n1 = MFMA32(a1, qf[ks], n1); }
                }
                if (do_cur) {
                    float rsum = 0.f;
#pragma unroll
                    for (int i = 0; i < 16; ++i) { s0[i] = __builtin_amdgcn_exp2f(s0[i] - mrun); s1[i] = __builtin_amdgcn_exp2f(s1[i] - mrun); rsum += s0[i] + s1[i]; }
                    lsum += rsum;
                    pw[0] = (u32x4){pk2(s0[0], s0[1]), pk2(s0[2], s0[3]), pk2(s0[4], s0[5]), pk2(s0[6], s0[7])};
                    pw[1] = (u32x4){pk2(s0[8], s0[9]), pk2(s0[10], s0[11]), pk2(s0[12], s0[13]), pk2(s0[14], s0[15])};
                    pw[2] = (u32x4){pk2(s1[0], s1[1]), pk2(s1[2], s1[3]), pk2(s1[4], s1[5]), pk2(s1[6], s1[7])};
                    pw[3] = (u32x4){pk2(s1[8], s1[9]), pk2(s1[10], s1[11]), pk2(s1[12], s1[13]), pk2(s1[14], s1[15])};
                }
                if constexpr (MODE == 1) {
#pragma unroll
                    for (int g = 0; g < 2 * NKS; ++g) { __builtin_amdgcn_sched_group_barrier(0x008, 1, 0); __builtin_amdgcn_sched_group_barrier(0x002, 7, 0); }
                }
                if (do_cur) {
#pragma unroll
                    for (int c = 0; c < VPRE; ++c)
#pragma unroll
                        for (int db = 0; db < NDB; ++db) O[db] = MFMA32(__builtin_bit_cast(bf16x8, vf[c][db]), __builtin_bit_cast(bf16x8, pw[c]), O[db]);
#pragma unroll
                    for (int c = VPRE; c < 4; ++c) {
                        u32x4 vg[NDB];
#pragma unroll
                        for (int db = 0; db < NDB; ++db) vg[db] = VFRAG(c, db);
#pragma unroll
                        for (int db = 0; db < NDB; ++db) O[db] = MFMA32(__builtin_bit_cast(bf16x8, vg[db]), __builtin_bit_cast(bf16x8, pw[c]), O[db]);
                    }
                }
#undef VFRAG
#undef KFRAG
                s0 = n0; s1 = n1;
                if (kt + 2 < kt_hi) LSTORE_K(j & 1);
                if (kt + 1 < kt_hi) LSTORE_V((j + 1) & 1);
                if (kt + 3 < kt_hi) GLOAD_K(kt + 3);
                if (kt + 2 < kt_hi) GLOAD_V(kt + 2);
                asm volatile("s_waitcnt lgkmcnt(0)" ::: "memory"); __builtin_amdgcn_s_barrier(); asm volatile("" ::: "memory");
            }
            const float ltot = lsum + shfl_idx(lsum, lane ^ 32), inv = 1.f / ltot;
#pragma unroll
            for (int db = 0; db < NDB; ++db)
#pragma unroll
                for (int i = 0; i < 16; ++i) O[db][i] *= inv;
            if constexpr (MODE == 3) {
                f32x4* stp = (f32x4*)(P.stash + ((size_t)bx * NTHREADS + tid) * 64);
                if (pass == 0) {
#pragma unroll
                    for (int db = 0; db < NDB; ++db)
#pragma unroll
                        for (int g = 0; g < 4; ++g) stp[db * 4 + g] = (f32x4){O[db][4 * g], O[db][4 * g + 1], O[db][4 * g + 2], O[db][4 * g + 3]};
                } else {
                    float ss = 0.f;
#pragma unroll
                    for (int db = 0; db < NDB; ++db) {
#pragma unroll
                        for (int g = 0; g < 4; ++g) { const f32x4 st = stp[db * 4 + g];
#pragma unroll
                            for (int j = 0; j < 4; ++j) { const float o = st[j] - lam * O[db][4 * g + j]; O[db][4 * g + j] = o; ss += o * o; } }
                        asm volatile("" ::: "memory");
                    }
                    ss += shfl_idx(ss, lane ^ 32);
                    const float rstd = rsqrtf(ss * (1.f / 128.f) + RMS_EPS) * (1.f - P.lambda_init);
                    bf16* orow = P.O + (size_t)(b * SEQ + qpos) * DM + head * 128;
#pragma unroll
                    for (int db = 0; db < NDB; ++db)
#pragma unroll
                        for (int g = 0; g < 4; ++g) {
                            const int d = db * 32 + 8 * g + 4 * h;
                            const f32x4 gn = *(const f32x4*)(P.subln + d);
                            u32x2 w; w.x = pk2(O[db][4 * g] * rstd * gn[0], O[db][4 * g + 1] * rstd * gn[1]); w.y = pk2(O[db][4 * g + 2] * rstd * gn[2], O[db][4 * g + 3] * rstd * gn[3]);
                            *(u32x2*)(orow + d) = w;
                        }
                }
            } else {
                int tok = qpos;
                if constexpr (MODE == 0) tok = (qpos % L) * dil + qpos / L;
                bf16* orow = P.O + (size_t)(b * SEQ + tok) * DM + head * 64;
#pragma unroll
                for (int db = 0; db < NDB; ++db)
#pragma unroll
                    for (int g = 0; g < 4; ++g) {
                        const int d = db * 32 + 8 * g + 4 * h;
                        u32x2 w; w.x = pk2(O[db][4 * g], O[db][4 * g + 1]); w.y = pk2(O[db][4 * g + 2], O[db][4 * g + 3]);
                        *(u32x2*)(orow + d) = w;
                    }
                if constexpr (MODE == 0) { if (h == 0) P.lse[(size_t)head * M + b * SEQ + tok] = mrun * (1.f / LOG2E) + __logf(ltot); }
            }
        }
    }
    __syncthreads();
#undef GLOAD_K
#undef GLOAD_V
#undef LSTORE_K
#undef LSTORE_V
#undef QK_TILE
#undef TILE_SKIP
}

__device__ __forceinline__ void tr_item(const float* W, int ldw, int col0, bf16* WT, int ldt, int row0, int k0, int n0, LAS float* scr, int lane, const float* gain) {
    const int c = lane & 7;
    f32x4 g0 = {1.f, 1.f, 1.f, 1.f}, g1 = g0;
    if (gain) { g0 = *(const f32x4*)(gain + k0 + 8 * c); g1 = *(const f32x4*)(gain + k0 + 8 * c + 4); }
    float wv[32];
    const float* wp = W + (size_t)(k0 + (lane >> 5)) * ldw + col0 + n0 + (lane & 31);
#pragma unroll
    for (int i = 0; i < 32; ++i) wv[i] = wp[(size_t)(2 * i) * ldw];
#pragma unroll
    for (int i = 0; i < 32; ++i) scr[(2 * i + (lane >> 5)) * 33 + (lane & 31)] = wv[i];
    asm volatile("s_waitcnt lgkmcnt(0)" ::: "memory");
#pragma unroll
    for (int j = 0; j < 4; ++j) { const int n = (lane >> 3) + 8 * j; const LAS float* s = scr + (8 * c) * 33 + n;
        u32x4 o; o.x = pk2(s[0 * 33] * g0[0], s[1 * 33] * g0[1]); o.y = pk2(s[2 * 33] * g0[2], s[3 * 33] * g0[3]); o.z = pk2(s[4 * 33] * g1[0], s[5 * 33] * g1[1]); o.w = pk2(s[6 * 33] * g1[2], s[7 * 33] * g1[3]);
        *(u32x4*)(WT + (size_t)(row0 + n0 + n) * ldt + k0 + 8 * c) = o; }
    asm volatile("s_waitcnt lgkmcnt(0)" ::: "memory");
}
__device__ __forceinline__ void tr_job(const float* W, int ldw, int col0, int ncols, int K, bf16* WT, int ldt, int row0, LAS float* scr, int lane, int gw, int ngw, const float* gain) {
    const int nblk = ncols / 32, nitems = (K / 64) * nblk;
    for (int it = gw; it < nitems; it += ngw) { const int kb = it / nblk, nb = it - kb * nblk; tr_item(W, ldw, col0, WT, ldt, row0, 64 * kb, 32 * nb, scr, lane, gain); }
}
__device__ __forceinline__ void rms_row_to_bf16(const float* xrow, const float* g, bf16* orow, int lane) {
    const f32x4* xr = (const f32x4*)xrow + lane; const f32x4* gr = (const f32x4*)g + lane;
    f32x4 v[4]; float s = 0.f;
#pragma unroll
    for (int j = 0; j < 4; ++j) { v[j] = xr[64 * j]; s += (v[j].x * v[j].x + v[j].y * v[j].y) + (v[j].z * v[j].z + v[j].w * v[j].w); }
    const float rstd = rsqrtf(wave_sum(s) * (1.f / DM) + RMS_EPS);
    unsigned long long* o8 = (unsigned long long*)orow + lane;
#pragma unroll
    for (int j = 0; j < 4; ++j) { const f32x4 gg = gr[64 * j];
        o8[64 * j] = (unsigned long long)pk2(v[j].x * rstd * gg.x, v[j].y * rstd * gg.y) | ((unsigned long long)pk2(v[j].z * rstd * gg.z, v[j].w * rstd * gg.w) << 32); }
}
__device__ __forceinline__ void norm_pass(const float* X, const float* g, bf16* HN, int lane, int gw, int ngw) {
    for (int m = gw; m < M; m += ngw) rms_row_to_bf16(X + (size_t)m * DM, g, HN + (size_t)m * DM, lane);
}
__device__ __forceinline__ void pconv_pass(const float* Pf, bf16* PB, int lane, int gw, int ngw) {
    for (int m = gw; m < M; m += ngw) { const f32x4 v = *((const f32x4*)(Pf + (size_t)m * 256) + lane);
        *((u32x2*)(PB + (size_t)m * 256) + lane) = (u32x2){pk2(v.x, v.y), pk2(v.z, v.w)}; }
}
__device__ __forceinline__ void final_norm_pass(float* X, const float* g, int lane, int gw, int ngw) {
    for (int m = gw; m < M; m += ngw) {
        f32x4* xr = (f32x4*)(X + (size_t)m * DM) + lane; const f32x4* gr = (const f32x4*)g + lane;
        f32x4 v[4]; float s = 0.f;
#pragma unroll
        for (int j = 0; j < 4; ++j) { v[j] = xr[64 * j]; s += (v[j].x * v[j].x + v[j].y * v[j].y) + (v[j].z * v[j].z + v[j].w * v[j].w); }
        const float rstd = rsqrtf(wave_sum(s) * (1.f / DM) + RMS_EPS);
#pragma unroll
        for (int j = 0; j < 4; ++j) { const f32x4 gg = gr[64 * j]; xr[64 * j] = (f32x4){v[j].x * rstd * gg.x, v[j].y * rstd * gg.y, v[j].z * rstd * gg.z, v[j].w * rstd * gg.w}; }
    }
}
__device__ __forceinline__ void mix_pass(bf16* O, const float* lse, int lane, int gw, int ngw) {
    for (int m = gw; m < M; m += ngw) {
#pragma unroll
        for (int it = 0; it < 2; ++it) {
            const int c = lane + 64 * it;
            u32x4* p = (u32x4*)(O + (size_t)m * DM) + c;
            if (c >= 120) { *p = (u32x4){0u, 0u, 0u, 0u}; continue; }
            const int head = c >> 3, hg = head % 5, g = head / 5;
            const float l0 = lse[(size_t)hg * M + m], l1 = lse[(size_t)(5 + hg) * M + m], l2 = lse[(size_t)(10 + hg) * M + m];
            const float mx = fmaxf(l0, fmaxf(l1, l2)), e0 = __expf(l0 - mx), e1 = __expf(l1 - mx), e2 = __expf(l2 - mx);
            const float a = (g == 0 ? e0 : (g == 1 ? e1 : e2)) / (e0 + e1 + e2);
            u32x4 w = *p;
            w.x = pk2(__uint_as_float(w.x << 16) * a, __uint_as_float(w.x & 0xffff0000u) * a); w.y = pk2(__uint_as_float(w.y << 16) * a, __uint_as_float(w.y & 0xffff0000u) * a);
            w.z = pk2(__uint_as_float(w.z << 16) * a, __uint_as_float(w.z & 0xffff0000u) * a); w.w = pk2(__uint_as_float(w.w << 16) * a, __uint_as_float(w.w & 0xffff0000u) * a);
            *p = w;
        }
    }
}
__device__ __forceinline__ void mla_norm_pass(const float* Z, const float* qg, const float* kvg, const float* tabl, bf16* CQN, bf16* CKVN, bf16* Kb, int lane, int gw, int ngw) {
    for (int m = gw; m < M; m += ngw) {
        const float* z = Z + (size_t)m * 512;
        const f32x4 a = *((const f32x4*)z + lane); const f32x2_t c = *((const f32x2_t*)(z + 256) + lane);
        const float rq = rsqrtf(wave_sum((a.x * a.x + a.y * a.y) + (a.z * a.z + a.w * a.w)) * (1.f / 256.f) + RMS_EPS);
        const float rk = rsqrtf(wave_sum(c.x * c.x + c.y * c.y) * (1.f / 128.f) + RMS_EPS);
        const f32x4 g4 = *((const f32x4*)qg + lane); const f32x2_t g2 = *((const f32x2_t*)kvg + lane);
        *((u32x2*)(CQN + (size_t)m * 256) + lane) = (u32x2){pk2(a.x * rq * g4.x, a.y * rq * g4.y), pk2(a.z * rq * g4.z, a.w * rq * g4.w)};
        *((unsigned*)(CKVN + (size_t)m * 128) + lane) = pk2(c.x * rk * g2.x, c.y * rk * g2.y);
        const int b = m >> 11, s = m & 2047; const int j = lane & 15;
        const float x1 = z[384 + j], x2 = z[400 + j], cs = tabl[s * 32 + j], sn = tabl[s * 32 + 16 + j];
        const float o1 = x1 * cs - x2 * sn, o2 = x2 * cs + x1 * sn;
        const int head = lane >> 2, j0 = (lane & 3) * 4;
        float r1[4], r2[4];
#pragma unroll
        for (int q = 0; q < 4; ++q) { r1[q] = shfl_idx(o1, j0 + q); r2[q] = shfl_idx(o2, j0 + q); }
        bf16* kr = Kb + ((size_t)(b * 16 + head) * SEQ + s) * 96 + 64;
        *(u32x2*)(kr + j0) = (u32x2){pk2(r1[0], r1[1]), pk2(r1[2], r1[3])};
        *(u32x2*)(kr + 16 + j0) = (u32x2){pk2(r2[0], r2[1]), pk2(r2[2], r2[3])};
    }
}

__device__ __forceinline__ void xb_rowss_pass(const float* Xs, bf16* XBo, float* RS, int lane, int gw, int ngw) {
    for (int m = gw; m < M; m += ngw) {
        const f32x4* xr = (const f32x4*)(Xs + (size_t)m * DM) + lane; f32x4 v[4]; float s = 0.f;
#pragma unroll
        for (int j = 0; j < 4; ++j) { v[j] = xr[64 * j]; s += (v[j].x * v[j].x + v[j].y * v[j].y) + (v[j].z * v[j].z + v[j].w * v[j].w); }
        s = wave_sum(s);
        unsigned long long* o8 = (unsigned long long*)(XBo + (size_t)m * DM) + lane;
#pragma unroll
        for (int j = 0; j < 4; ++j) o8[64 * j] = (unsigned long long)pk2(v[j].x, v[j].y) | ((unsigned long long)pk2(v[j].z, v[j].w) << 32);
        if (lane < 16) RS[(size_t)m * 16 + lane] = (lane == 0) ? s : 0.f;
    }
}
__device__ __forceinline__ void final_norm_rs_pass(const bf16* XBs, float* Out, const float* g, const float* RS, int lane, int gw, int ngw) {
    for (int m = gw; m < M; m += ngw) {
        const u32x2* xr = (const u32x2*)(XBs + (size_t)m * DM) + lane; f32x4* orow = (f32x4*)(Out + (size_t)m * DM) + lane; const f32x4* gr = (const f32x4*)g + lane;
        const float rstd = rsqrtf(rowsum16(RS + (size_t)m * 16) * (1.f / DM) + RMS_EPS);
#pragma unroll
        for (int j = 0; j < 4; ++j) { const u32x2 w = xr[64 * j]; const f32x4 gg = gr[64 * j];
            orow[64 * j] = (f32x4){__uint_as_float(w.x << 16) * rstd * gg.x, __uint_as_float(w.x & 0xffff0000u) * rstd * gg.y, __uint_as_float(w.y << 16) * rstd * gg.z, __uint_as_float(w.y & 0xffff0000u) * rstd * gg.w}; }
    }
}

struct TrState { float wv[32]; f32x4 g0, g1; bf16* dst; int ldt; };
struct TrJob { int idx; unsigned src_off; int ldw, col0, ncols, K; unsigned dst_off; int ldt, row0, gidx, goff, item0; };
constexpr int N_TRJOBS = 60;
constexpr int N_TR_ITEMS = 26000;
__constant__ TrJob tr_jobs[N_TRJOBS + 1] = {
    {3, 0u, 2880, 0, 1920, 1024, 4194304u, 1024, 0, 2, 0, 0},
    {3, 0u, 2880, 1920, 960, 1024, 8388608u, 1024, 0, 2, 0, 960},
    {4, 0u, 1024, 0, 1024, 960, 10485760u, 1024, 0, -1, 0, 1440},
    {6, 0u, 416, 0, 416, 1024, 12582912u, 1024, 0, 5, 0, 1920},
    {8, 0u, 1536, 0, 1536, 256, 13631488u, 256, 0, -1, 0, 2128},
    {10, 0u, 2048, 0, 64, 128, 14417920u, 128, 0, -1, 0, 2320},
    {10, 0u, 2048, 64, 64, 128, 14680064u, 128, 0, -1, 0, 2324},
    {10, 0u, 2048, 128, 64, 128, 14417920u, 128, 64, -1, 0, 2328},
    {10, 0u, 2048, 192, 64, 128, 14680064u, 128, 64, -1, 0, 2332},
    {10, 0u, 2048, 256, 64, 128, 14417920u, 128, 128, -1, 0, 2336},
    {10, 0u, 2048, 320, 64, 128, 14680064u, 128, 128, -1, 0, 2340},
    {10, 0u, 2048, 384, 64, 128, 14417920u, 128, 192, -1, 0, 2344},
    {10, 0u, 2048, 448, 64, 128, 14680064u, 128, 192, -1, 0, 2348},
    {10, 0u, 2048, 512, 64, 128, 14417920u, 128, 256, -1, 0, 2352},
    {10, 0u, 2048, 576, 64, 128, 14680064u, 128, 256, -1, 0, 2356},
    {10, 0u, 2048, 640, 64, 128, 14417920u, 128, 320, -1, 0, 2360},
    {10, 0u, 2048, 704, 64, 128, 14680064u, 128, 320, -1, 0, 2364},
    {10, 0u, 2048, 768, 64, 128, 14417920u, 128, 384, -1, 0, 2368},
    {10, 0u, 2048, 832, 64, 128, 14680064u, 128, 384, -1, 0, 2372},
    {10, 0u, 2048, 896, 64, 128, 14417920u, 128, 448, -1, 0, 2376},
    {10, 0u, 2048, 960, 64, 128, 14680064u, 128, 448, -1, 0, 2380},
    {10, 0u, 2048, 1024, 64, 128, 14417920u, 128, 512, -1, 0, 2384},
    {10, 0u, 2048, 1088, 64, 128, 14680064u, 128, 512, -1, 0, 2388},
    {10, 0u, 2048, 1152, 64, 128, 14417920u, 128, 576, -1, 0, 2392},
    {10, 0u, 2048, 1216, 64, 128, 14680064u, 128, 576, -1, 0, 2396},
    {10, 0u, 2048, 1280, 64, 128, 14417920u, 128, 640, -1, 0, 2400},
    {10, 0u, 2048, 1344, 64, 128, 14680064u, 128, 640, -1, 0, 2404},
    {10, 0u, 2048, 1408, 64, 128, 14417920u, 128, 704, -1, 0, 2408},
    {10, 0u, 2048, 1472, 64, 128, 14680064u, 128, 704, -1, 0, 2412},
    {10, 0u, 2048, 1536, 64, 128, 14417920u, 128, 768, -1, 0, 2416},
    {10, 0u, 2048, 1600, 64, 128, 14680064u, 128, 768, -1, 0, 2420},
    {10, 0u, 2048, 1664, 64, 128, 14417920u, 128, 832, -1, 0, 2424},
    {10, 0u, 2048, 1728, 64, 128, 14680064u, 128, 832, -1, 0, 2428},
    {10, 0u, 2048, 1792, 64, 128, 14417920u, 128, 896, -1, 0, 2432},
    {10, 0u, 2048, 1856, 64, 128, 14680064u, 128, 896, -1, 0, 2436},
    {10, 0u, 2048, 1920, 64, 128, 14417920u, 128, 960, -1, 0, 2440},
    {10, 0u, 2048, 1984, 64, 128, 14680064u, 128, 960, -1, 0, 2444},
    {11, 0u, 1024, 0, 1024, 1024, 14942208u, 1024, 0, -1, 0, 2448},
    {13, 0u, 3072, 0, 2048, 1024, 17039360u, 1024, 0, 12, 0, 2960},
    {13, 0u, 3072, 2048, 1024, 1024, 21233664u, 1024, 0, 12, 0, 3984},
    {15, 0u, 1024, 0, 1024, 1024, 23330816u, 1024, 0, -1, 0, 4496},
    {17, 0u, 3072, 0, 2048, 1024, 25427968u, 1024, 0, 16, 0, 5008},
    {17, 0u, 3072, 2048, 1024, 1024, 29622272u, 1024, 0, 16, 0, 6032},
    {23, 0u, 1024, 0, 1024, 1024, 31719424u, 1024, 0, -1, 0, 6544},
    {25, 0u, 4096, 0, 4096, 1024, 33816576u, 1024, 0, 24, 0, 7056},
    {26, 0u, 1024, 0, 1024, 4096, 42205184u, 4096, 0, -1, 0, 9104},
    {28, 0u, 1024, 0, 1024, 1024, 50593792u, 1024, 0, 27, 0, 11152},
    {29, 0u, 1024, 0, 1024, 256, 52690944u, 256, 0, -1, 0, 11664},
    {25, 4194304u, 4096, 0, 4096, 1024, 53215232u, 1024, 0, 24, 1024, 11792},
    {26, 4194304u, 1024, 0, 1024, 4096, 61603840u, 4096, 0, -1, 0, 13840},
    {28, 1048576u, 1024, 0, 1024, 1024, 69992448u, 1024, 0, 27, 1024, 15888},
    {29, 262144u, 1024, 0, 1024, 256, 72089600u, 256, 0, -1, 0, 16400},
    {25, 8388608u, 4096, 0, 4096, 1024, 72613888u, 1024, 0, 24, 2048, 16528},
    {26, 8388608u, 1024, 0, 1024, 4096, 81002496u, 4096, 0, -1, 0, 18576},
    {28, 2097152u, 1024, 0, 1024, 1024, 89391104u, 1024, 0, 27, 2048, 20624},
    {29, 524288u, 1024, 0, 1024, 256, 91488256u, 256, 0, -1, 0, 21136},
    {25, 12582912u, 4096, 0, 4096, 1024, 92012544u, 1024, 0, 24, 3072, 21264},
    {26, 12582912u, 1024, 0, 1024, 4096, 100401152u, 4096, 0, -1, 0, 23312},
    {28, 3145728u, 1024, 0, 1024, 1024, 108789760u, 1024, 0, 27, 3072, 25360},
    {29, 786432u, 1024, 0, 1024, 256, 110886912u, 256, 0, -1, 0, 25872},
    {0, 0u, 0, 0, 32, 64, 0u, 0, 0, -1, 0, 26000},
};

#ifndef REP_ATTN_A
#define REP_ATTN_A 1
#endif
#ifndef REP_ATTN_B
#define REP_ATTN_B 1
#endif
#ifndef REP_ATTN_C
#define REP_ATTN_C 1
#endif
#ifndef REP_ATTN_D
#define REP_ATTN_D 1
#endif
#ifndef REP_P0
#define REP_P0 1
#endif
#ifndef REP_QKV
#define REP_QKV 1
#endif
#ifndef REP_UP
#define REP_UP 1
#endif
#ifndef REP_SYNC
#define REP_SYNC 1
#endif
struct Args { const float* in[31]; float* out; unsigned char* ws; int ph_lo, ph_hi; };
#define CAS __attribute__((address_space(4)))
__device__ __forceinline__ const float* in_ptr(int idx) {
    const CAS char* ka = (const CAS char*)__builtin_amdgcn_kernarg_segment_ptr(); asm volatile("" : "+s"(ka));
    return (const float*)*(const __attribute__((address_space(1))) float* const CAS*)(ka + idx * 8);
}

__global__ void __launch_bounds__(NTHREADS, 2) fwd_kernel(Args args) {
    extern __shared__ __attribute__((aligned(16))) unsigned char lds_raw[];
    LAS unsigned char* lds = (LAS unsigned char*)lds_raw;
    cg::grid_group grid = cg::this_grid();
#define XOUT ((float*)(__attribute__((address_space(1))) float*)args.out)
#define XD ((bf16*)(__attribute__((address_space(1))) bf16*)args.out)
#define HN ((bf16*)(ws + WS_HN))
#define PB ((bf16*)(ws + WS_PB))
#define Qb ((bf16*)(ws + WS_BIG + BIG_Q))
#define Kb ((bf16*)(ws + WS_BIG + BIG_K))
#define Vb ((bf16*)(ws + WS_BIG + BIG_V))
#define Ob ((bf16*)(ws + WS_BIG + BIG_O))
#define Hb ((bf16*)(ws + WS_BIG))
#define Tb ((bf16*)(ws + WS_BIG + BIG_O))
#define XBM ((bf16*)(ws + WS_BIG + BIG_O))
#define RS(i) ((float*)(ws + WS_RS) + (size_t)((i) % 3) * M * 16)
#define Zb ((float*)(ws + WS_HN))
#define CQN ((bf16*)(ws + WS_BIG + BIG_O))
#define CKVN ((bf16*)(ws + WS_BIG + BIG_O + 8 * MiB))
#define tabp ((float*)(ws + WS_TABP))
#define tabl ((float*)(ws + WS_TABL))
#define lse ((float*)(ws + WS_LSE))
    const int wave_s = __builtin_amdgcn_readfirstlane(threadIdx.x >> 6);
    volatile LAS unsigned* xb_st = (volatile LAS unsigned*)(lds + 131072 + 64);
    if (threadIdx.x == 0) { xb_st[0] = 0u; xb_st[1] = 0u; }
    __syncthreads();
    XcdBarrier xb = xcd_barrier_post((unsigned*)args.ws, xb_st, threadIdx.x == 0);
    int ph = 0;
#define run_gemm(MODE, ...) run_gemm_<MODE>(__VA_ARGS__, wave_s)
#define attn_phase(MODE, ...) attn_phase_<MODE>(__VA_ARGS__, wave_s * 64 + lane_id_here())
#define PHASE_BEGIN if (ph >= args.ph_lo && ph < args.ph_hi) { __attribute__((address_space(1))) unsigned char* wsg_ = (__attribute__((address_space(1))) unsigned char*)args.ws; int bx_ = blockIdx.x, gx_ = gridDim.x; asm volatile("" : "+s"(wsg_), "+s"(bx_), "+s"(gx_)); unsigned char* ws = (unsigned char*)wsg_; \
    const int lane = lane_id_here(), wave = wave_s, tid = wave * 64 + lane, gw = bx_ * NWAVES + wave, ngw = gx_ * NWAVES; \
    LAS float* scr = (LAS float*)(lds + wave * 16384); (void)scr; (void)lane; (void)gw; (void)ngw;
#define PHASE_BEGIN_R(n) PHASE_BEGIN for (int rp_ = 0; rp_ < (n); ++rp_) {
#define PHASE_END_R } PHASE_END
#define PHASE_END   if (ph + 1 < args.ph_hi) { for (int rs_ = 0; rs_ < REP_SYNC; ++rs_) { if (ph == 0) grid.sync(); else xcd_barrier(xb, wave_s == 0 && lane_id_here() == 0); } } } ++ph;
#define WB(off) ((bf16*)(ws + (off)))
#define TR(idx, ldw, col0, ncols, K, dst, ldt, row0) tr_job(in_ptr(idx), ldw, col0, ncols, K, WB(dst), ldt, row0, scr, lane, gw, ngw)

    PHASE_BEGIN_R(REP_P0)
        {
            int jcur = 0;
#define TR_LOAD(S_, it_) do { while (tr_jobs[jcur + 1].item0 <= (it_)) ++jcur; const TrJob jb = tr_jobs[jcur]; \
                const int loc = (it_) - jb.item0, nblk = jb.ncols >> 5, kb = loc / nblk, nb = loc - kb * nblk, k0 = 64 * kb, n0 = 32 * nb; \
                const float* wp = in_ptr(jb.idx) + jb.src_off + (size_t)(k0 + (lane >> 5)) * jb.ldw + jb.col0 + n0 + (lane & 31); \
                _Pragma("unroll") for (int i = 0; i < 32; ++i) S_.wv[i] = wp[(size_t)(2 * i) * jb.ldw]; \
                S_.g0 = (f32x4){1.f, 1.f, 1.f, 1.f}; S_.g1 = S_.g0; \
                if (jb.gidx >= 0) { const float* gp = in_ptr(jb.gidx) + jb.goff + k0 + 8 * (lane & 7); S_.g0 = *(const f32x4*)gp; S_.g1 = *(const f32x4*)(gp + 4); } \
                S_.dst = (bf16*)(ws + jb.dst_off) + (size_t)(jb.row0 + n0) * jb.ldt + k0 + 8 * (lane & 7); S_.ldt = jb.ldt; } while (0)
#define TR_FINISH(S_) do { _Pragma("unroll") for (int i = 0; i < 32; ++i) scr[(2 * i + (lane >> 5)) * 33 + (lane & 31)] = S_.wv[i]; \
                asm volatile("s_waitcnt lgkmcnt(0)" ::: "memory"); \
                _Pragma("unroll") for (int j = 0; j < 4; ++j) { const int n = (lane >> 3) + 8 * j; const LAS float* sp = scr + (8 * (lane & 7)) * 33 + n; \
                    u32x4 o; o.x = pk2(sp[0 * 33] * S_.g0[0], sp[1 * 33] * S_.g0[1]); o.y = pk2(sp[2 * 33] * S_.g0[2], sp[3 * 33] * S_.g0[3]); \
                    o.z = pk2(sp[4 * 33] * S_.g1[0], sp[5 * 33] * S_.g1[1]); o.w = pk2(sp[6 * 33] * S_.g1[2], sp[7 * 33] * S_.g1[3]); \
                    *(u32x4*)(S_.dst + (size_t)n * S_.ldt) = o; } \
                asm volatile("s_waitcnt lgkmcnt(0)" ::: "memory"); } while (0)
            TrState A, B;
            int it = gw;
            if (it < N_TR_ITEMS) TR_LOAD(A, it);
            while (it < N_TR_ITEMS) {
                int nxt = it + ngw; if (nxt < N_TR_ITEMS) TR_LOAD(B, nxt);
                TR_FINISH(A);
                it = nxt; if (it >= N_TR_ITEMS) break;
                nxt = it + ngw; if (nxt < N_TR_ITEMS) TR_LOAD(A, nxt);
                TR_FINISH(B);
                it = nxt;
            }
#undef TR_LOAD
#undef TR_FINISH
        }
        for (int i = bx_ * NTHREADS + tid; i < 1024 * 8; i += gx_ * NTHREADS) *((u32x4*)(WB(W_A_O) + (size_t)(i >> 3) * 1024 + 960) + (i & 7)) = (u32x4){0u, 0u, 0u, 0u};
        for (int i = bx_ * NTHREADS + tid; i < SEQ * 24; i += gx_ * NTHREADS) {
            const int s = i / 24, r = i - s * 24;
            const bool isl = r >= 8; const int j = isl ? r - 8 : r; const float rot = isl ? 32.f : 16.f;
            const float inv = exp2f(-(2.f * (float)j / rot) * 18.931568569324174f);
            double rev = (double)s * (double)inv * 0.15915494309189535; rev -= floor(rev);
            const float cs = __builtin_amdgcn_cosf((float)rev), sn = __builtin_amdgcn_sinf((float)rev);
            if (isl) { tabl[s * 32 + j] = cs; tabl[s * 32 + 16 + j] = sn; } else { tabp[s * 16 + j] = cs; tabp[s * 16 + 8 + j] = sn; }
        }
        xb_rowss_pass(in_ptr(0), XBM, RS(0), lane, gw, ngw);
    PHASE_END_R

#pragma unroll
    for (int layer = 0; layer < 4; ++layer) {
        if (layer == 0) {
            PHASE_BEGIN_R(REP_QKV)
                { EpiP e{Qb, Kb, nullptr, tabp, 0, 960, 960, 15, 64, 1, 1, 64, RS(0), nullptr, nullptr, LOG2E * 0.125f}; run_gemm(EPI_QK, lds, XBM, WB(W_A_QK), M, 2048, DM, e); }
                { EpiP e{Vb, nullptr, nullptr, nullptr, 0, 960, 0, 15, 0, 0, 1, 64, RS(0), nullptr, nullptr}; run_gemm(EPI_VT, lds, WB(W_A_V), XBM, 1024, M, DM, e); }
            PHASE_END_R
            PHASE_BEGIN
                { AttnP a{Qb, Kb, Vb, Ob, lse, nullptr, nullptr, nullptr, nullptr, nullptr, nullptr, nullptr, 0.f, 0}; for (int rep_ = 0; rep_ < REP_ATTN_A; ++rep_) attn_phase(0, lds, a); }
            PHASE_END
            PHASE_BEGIN
                mix_pass(Ob, lse, lane, gw, ngw);
            PHASE_END
            PHASE_BEGIN
                { EpiP e{nullptr, nullptr, in_ptr(0), nullptr, DM, 0, 0, 0, 0, 1, 0, 0, nullptr, RS(1), HN}; run_gemm(EPI_RESID, lds, Ob, WB(W_A_O), M, DM, DM, e); }
                pconv_pass(in_ptr(1), PB, lane, gw, ngw);
            PHASE_END
        } else if (layer == 1) {
            PHASE_BEGIN
                { EpiP e{Zb, nullptr, nullptr, nullptr, 512, 0, 0, 0, 0, 0, 0, 0, RS(3), nullptr, nullptr}; run_gemm(EPI_F32, lds, XD, WB(W_B_IN), M, 512, DM, e); }
            PHASE_END
            PHASE_BEGIN
                mla_norm_pass(Zb, in_ptr(7), in_ptr(9), tabl, CQN, CKVN, Kb, lane, gw, ngw);
            PHASE_END
            PHASE_BEGIN
                { EpiP e{Qb, nullptr, nullptr, tabl, 0, 0, 0, 16, 96, 1, 0, 0, nullptr, nullptr, nullptr, LOG2E * 0.10206207261596575f}; run_gemm(EPI_MLAQ, lds, CQN, WB(W_B_UQ), M, 1536, 256, e); }
                { EpiP e{nullptr, Kb, nullptr, nullptr, 0, 0, 1024, 16, 96, 0, 0, 0, nullptr, nullptr, nullptr}; run_gemm(EPI_QK, lds, CKVN, WB(W_B_K), M, 1024, 128, e); }
                { EpiP e{Vb, nullptr, nullptr, nullptr, 0, 1024, 0, 16, 0, 0, 0, 64, nullptr, nullptr, nullptr}; run_gemm(EPI_VT, lds, WB(W_B_V), CKVN, 1024, M, 128, e); }
            PHASE_END
            PHASE_BEGIN
                { AttnP a{Qb, Kb, Vb, Ob, nullptr, nullptr, nullptr, nullptr, nullptr, nullptr, nullptr, nullptr, 0.f, 0}; for (int rep_ = 0; rep_ < REP_ATTN_B; ++rep_) attn_phase(1, lds, a); }
            PHASE_END
            PHASE_BEGIN
                { EpiP e{nullptr, nullptr, XD, nullptr, DM, 0, 0, 0, 0, 0, 0, 0, nullptr, RS(4), HN}; run_gemm(EPI_RESID, lds, Ob, WB(W_B_O), M, DM, DM, e); }
                pconv_pass(in_ptr(1) + (size_t)1 * M * 256, PB, lane, gw, ngw);
            PHASE_END
        } else if (layer == 2) {
            PHASE_BEGIN_R(REP_QKV)
                { EpiP e{Qb, Kb, nullptr, nullptr, 0, 1024, 1024, 16, 64, 0, 0, 64, RS(6), nullptr, nullptr, LOG2E * 0.125f}; run_gemm(EPI_QK, lds, XD, WB(W_C_QK), M, 2048, DM, e); }
                { EpiP e{Vb, nullptr, nullptr, nullptr, 0, 1024, 0, 16, 0, 0, 0, 64, RS(6), nullptr, nullptr}; run_gemm(EPI_VT, lds, WB(W_C_V), XD, 1024, M, DM, e); }
            PHASE_END_R
            PHASE_BEGIN
                { AttnP a{Qb, Kb, Vb, Ob, nullptr, in_ptr(14), nullptr, nullptr, nullptr, nullptr, nullptr, nullptr, 0.f, 0}; for (int rep_ = 0; rep_ < REP_ATTN_C; ++rep_) attn_phase(2, lds, a); }
            PHASE_END
            PHASE_BEGIN
                { EpiP e{nullptr, nullptr, XD, nullptr, DM, 0, 0, 0, 0, 0, 0, 0, nullptr, RS(7), HN}; run_gemm(EPI_RESID, lds, Ob, WB(W_C_O), M, DM, DM, e); }
                pconv_pass(in_ptr(1) + (size_t)2 * M * 256, PB, lane, gw, ngw);
            PHASE_END
        } else {
            PHASE_BEGIN_R(REP_QKV)
                { EpiP e{Qb, Kb, nullptr, tabp, 0, 1024, 1024, 16, 64, 1, 0, 64, RS(9), nullptr, nullptr, LOG2E * 0.125f}; run_gemm(EPI_QK, lds, XD, WB(W_D_QK), M, 2048, DM, e); }
                { EpiP e{Vb, nullptr, nullptr, nullptr, 0, 1024, 0, 8, 0, 0, 0, 128, RS(9), nullptr, nullptr}; run_gemm(EPI_VT, lds, WB(W_D_V), XD, 1024, M, DM, e); }
            PHASE_END_R
            PHASE_BEGIN
                { const float li = 0.8f - 0.6f * 0.40656965974059917f;
                  AttnP a{Qb, Kb, Vb, Ob, nullptr, nullptr, in_ptr(18), in_ptr(19), in_ptr(20), in_ptr(21), in_ptr(22), (float*)HN, li, 0}; for (int rep_ = 0; rep_ < REP_ATTN_D; ++rep_) attn_phase(3, lds, a); }
            PHASE_END
            PHASE_BEGIN
                { EpiP e{nullptr, nullptr, XD, nullptr, DM, 0, 0, 0, 0, 0, 0, 0, nullptr, RS(10), HN}; run_gemm(EPI_RESID, lds, Ob, WB(W_D_O), M, DM, DM, e); }
                pconv_pass(in_ptr(1) + (size_t)3 * M * 256, PB, lane, gw, ngw);
            PHASE_END
        }
        const size_t wl = W_L + (size_t)layer * W_L_STRIDE;
        PHASE_BEGIN_R(REP_UP)
            { EpiP e{Hb, nullptr, nullptr, nullptr, FF, 0, 0, 0, 0, 0, 0, 0, RS(3 * layer + 1), nullptr, nullptr}; run_gemm(EPI_SQRELU, lds, HN, WB(wl + W_L_UP), M, FF, DM, e); }
            { EpiP e{Tb, nullptr, nullptr, nullptr, DM, 0, 0, 0, 0, 0, 0, 0, nullptr, nullptr, nullptr}; run_gemm(EPI_BF16, lds, PB, WB(wl + W_L_PROJ), M, DM, 256, e); }
        PHASE_END_R
        PHASE_BEGIN
            { EpiP e{nullptr, nullptr, HN, nullptr, DM, 0, 0, 0, 0, 0, 0, 0, nullptr, RS(3 * layer + 2), HN}; run_gemm(EPI_RESID, lds, Hb, WB(wl + W_L_DOWN), M, DM, FF, e); }
        PHASE_END
        PHASE_BEGIN
            { EpiP e{nullptr, HN, Tb, nullptr, DM, 0, 0, 0, 0, 0, 0, 0, RS(3 * layer + 2), RS(3 * layer + 3), (layer < 3) ? XD : XBM}; run_gemm(EPI_GATE, lds, HN, WB(wl + W_L_GATE), M, DM, DM, e); }
        PHASE_END
    }
    PHASE_BEGIN
        final_norm_rs_pass(XBM, XOUT, in_ptr(30), RS(12), lane, gw, ngw);
    PHASE_END
}
constexpr int N_PHASES = 1 + 4 + 5 + 3 + 3 + 4 * 3 + 1;

#ifndef MULTI_LAUNCH
#define MULTI_LAUNCH 0
#endif
extern "C" void kernel_launch(void* const* d_in, const int* in_sizes, int n_in, void* d_out, int out_size, void* d_ws, size_t ws_size, hipStream_t stream) {
    static int grid = 0;
    if (grid == 0) {
        if (n_in != 31 || ws_size < WS_END) { fprintf(stderr, "kernel_launch: unexpected inputs (n_in %d, ws %zu, need %zu)\n", n_in, ws_size, (size_t)WS_END); grid = -1; return; }
        int dev = 0, cus = 0, per_cu = 0;
        hipGetDevice(&dev); hipDeviceGetAttribute(&cus, hipDeviceAttributeMultiprocessorCount, dev);
        if (hipFuncSetAttribute((const void*)fwd_kernel, hipFuncAttributeMaxDynamicSharedMemorySize, LDS_BYTES) != hipSuccess) { fprintf(stderr, "kernel_launch: hipFuncSetAttribute failed\n"); grid = -1; return; }
        hipOccupancyMaxActiveBlocksPerMultiprocessor(&per_cu, (const void*)fwd_kernel, NTHREADS, LDS_BYTES);
        (void)hipGetLastError();
        if (per_cu < 1) per_cu = 1;
        grid = cus * 1;
        fprintf(stderr, "kernel_launch: cus %d per_cu %d grid %d\n", cus, per_cu, grid);
    }
    if (grid < 0) return;
    if (hipMemsetAsync(d_ws, 0, 16384, stream) != hipSuccess) { fprintf(stderr, "kernel_launch: memset of the barrier words failed\n"); return; }
    Args a{};
    for (int i = 0; i < 31; ++i) a.in[i] = (const float*)d_in[i];
    a.out = (float*)d_out; a.ws = (unsigned char*)d_ws;
#if MULTI_LAUNCH
    for (int p = 0; p < N_PHASES; ++p) { a.ph_lo = p; a.ph_hi = p + 1; hipLaunchKernelGGL(fwd_kernel, dim3(grid), dim3(NTHREADS), LDS_BYTES, stream, a); }
#else
    a.ph_lo = 0; a.ph_hi = N_PHASES;
    void* kargs[] = {&a};
    hipError_t e = hipLaunchCooperativeKernel((const void*)fwd_kernel, dim3(grid), dim3(NTHREADS), kargs, LDS_BYTES, stream);
    if (e != hipSuccess) fprintf(stderr, "cooperative launch failed: %s (grid %d)\n", hipGetErrorString(e), grid);
#endif
}
```

```cpp
#include <hip/hip_runtime.h>
#include <hip/hip_cooperative_groups.h>
#include <cstdio>
#include <cstdint>
namespace cg = cooperative_groups;

namespace pg8 {
#define PG8_LAS __attribute__((address_space(3)))
typedef unsigned short bf16_t;
typedef short bf16x8 __attribute__((ext_vector_type(8)));
typedef float f32x4 __attribute__((ext_vector_type(4)));
typedef unsigned u32x4 __attribute__((ext_vector_type(4)));
constexpr int BM = 256, BK = 64, HALF = 128, HTB = HALF * BK * 2  , STAGE_BYTES = 8 * HTB, NXCD = 8, WGM = 8;

__host__ __device__ __forceinline__ int lds_byte(int r, int c) { const int st = (r >> 4) * 2 + (c >> 5), rr = r & 15, cc = c & 31, ob = rr * 64 + cc * 2; return st * 1024 + (ob ^ (((ob >> 9) & 1) << 5)); }
__host__ __device__ __forceinline__ void stage_rc(int b, int& R, int& C) { const int st = b / 1024, sb = b % 1024, swz = sb ^ (((sb >> 9) & 1) << 5); R = (st >> 1) * 16 + swz / 64; C = (st & 1) * 32 + (swz % 64) / 2; }
__host__ __device__ __forceinline__ int perm32(int rho) { const int n = rho >> 4, i = rho & 15; return 8 * (i >> 2) + 4 * n + (i & 3); }

struct Unit { int pm, pn; };
struct Gemm { const bf16_t* A; const bf16_t* Bt; int M, N, K; };

struct StaticOrder {
    int nM, nN, nwg, G, c;
    __host__ __device__ void init(int M, int N, int G_, int c_) { nM = M / BM; nN = N / BM; nwg = nM * nN; G = G_; c = c_; }
    __host__ __device__ bool next(int i, Unit& u) const {
        const long L = (long)i * G + c; if (L >= nwg) return false;
        int wgid = (int)L; { const int q = nwg / NXCD, r = nwg % NXCD, xcd = wgid % NXCD, off = wgid / NXCD; wgid = (xcd < r ? xcd * (q + 1) : r * (q + 1) + (xcd - r) * q) + off; }
        const int nig = WGM * nN, gid = wgid / nig, fm = gid * WGM, gsz = (nM - fm) < WGM ? (nM - fm) : WGM;
        u.pm = fm + ((wgid % nig) % gsz); u.pn = (wgid % nig) / gsz; return true;
    }
    __device__ __forceinline__ void a_ready(const Unit&) const {}
    __device__ __forceinline__ void done(const Unit&) const {}
};

template <class Epi, class Sched, bool ALIGN_EPI = false, bool SP2 = false>
__device__ __forceinline__ void gemm_phase(PG8_LAS unsigned char* lds, const Gemm g, const Sched& S, const Epi& E, const int tid_in) {
    int tid_o = tid_in; asm volatile("" : "+v"(tid_o));
    const int tid = tid_o, wid = __builtin_amdgcn_readfirstlane(tid >> 6), lane = tid & 63, wr = wid >> 2, wc = wid & 3, fr = lane & 15, fq = lane >> 4;
    const int K = g.K, nt = K / BK;
    unsigned voffA[2], voffB[2];
#pragma unroll
    for (int i = 0; i < 2; ++i) { int R, C; stage_rc(tid * 16 + i * 8192, R, C); const int Rb = Epi::PERM ? ((R & ~31) + perm32(R & 31)) : R;
        voffA[i] = (unsigned)(R * K + C) * 2u; voffB[i] = (unsigned)(Rb * K + C) * 2u; }
    const size_t kstep = (size_t)(BK * 2);
    const size_t hstep = (size_t)HALF * K * 2;
    const size_t tstep = 2 * hstep;
    const unsigned ldsw = (unsigned)wid * 1024u;
    const int aoff = lds_byte(wr * 64 + fr, fq * 8), boff = lds_byte(wc * 32 + fr, fq * 8);
#define PG8_SA(b, h) (((b) * 2 + (h)) * HTB)
#define PG8_SB(b, h) ((4 + (b) * 2 + (h)) * HTB)
#define PG8_STAGE(bufoff, gbase, voff) do { _Pragma("unroll") for (int _i = 0; _i < 2; ++_i) \
        __builtin_amdgcn_global_load_lds((const unsigned*)((const char*)(gbase) + (voff)[_i]), (PG8_LAS unsigned*)(lds + (bufoff) + ldsw + _i * 8192), 16, 0, 0); } while (0)
#define PG8_LDA(dst, b, h) do { _Pragma("unroll") for (int m = 0; m < 4; ++m) _Pragma("unroll") for (int k = 0; k < 2; ++k) dst[m][k] = *(const PG8_LAS bf16x8*)(lds + PG8_SA(b, h) + aoff + m * 2048 + k * 1024); } while (0)
#define PG8_LDB(dst, b, h) do { _Pragma("unroll") for (int n = 0; n < 2; ++n) _Pragma("unroll") for (int k = 0; k < 2; ++k) dst[n][k] = *(const PG8_LAS bf16x8*)(lds + PG8_SB(b, h) + boff + n * 2048 + k * 1024); } while (0)
#define PG8_MMA(ai, bj, At, Bt) do { __builtin_amdgcn_s_setprio(1); _Pragma("unroll") for (int m = 0; m < 4; ++m) _Pragma("unroll") for (int n = 0; n < 2; ++n) _Pragma("unroll") for (int k = 0; k < 2; ++k) \
        acc[ai][bj][m][n] = __builtin_amdgcn_mfma_f32_16x16x32_bf16(Bt[n][k], At[m][k], acc[ai][bj][m][n], 0, 0, 0); __builtin_amdgcn_s_setprio(0); } while (0)
#define PG8_WAIT_V(n) asm volatile("s_waitcnt vmcnt(" #n ")" ::: "memory")
#define PG8_WAIT_L(n) asm volatile("s_waitcnt lgkmcnt(" #n ")" ::: "memory")
#define PG8_BAR __builtin_amdgcn_s_barrier()
#define PG8_SCHED __builtin_amdgcn_sched_barrier(0)
    Unit cur, nxt; int ui = 0;
    if (!S.next(0, cur)) return;
    f32x4 acc[2][2][4][2];
#pragma unroll
    for (int a = 0; a < 2; ++a)
#pragma unroll
        for (int b = 0; b < 2; ++b)
#pragma unroll
            for (int m = 0; m < 4; ++m)
#pragma unroll
                for (int n = 0; n < 2; ++n) acc[a][b][m][n] = (f32x4){0.f, 0.f, 0.f, 0.f};
    bf16x8 At[4][2], B0[2][2], B1[2][2];
    const char* cA = (const char*)g.A + (size_t)cur.pm * tstep; const char* cB = (const char*)g.Bt + (size_t)cur.pn * tstep;
    S.a_ready(cur);
    if constexpr (SP2) {
        PG8_STAGE(PG8_SB(0, 0), cB, voffB); PG8_STAGE(PG8_SB(0, 1), cB + hstep, voffB); PG8_STAGE(PG8_SA(0, 0), cA, voffA); PG8_STAGE(PG8_SA(0, 1), cA + hstep, voffA);
        if (wr == 1) PG8_BAR;
        PG8_WAIT_V(2); PG8_BAR;
        PG8_STAGE(PG8_SB(1, 0), cB + kstep, voffB); PG8_STAGE(PG8_SA(1, 0), cA + kstep, voffA); PG8_STAGE(PG8_SB(1, 1), cB + hstep + kstep, voffB);
        PG8_WAIT_V(6); PG8_BAR;
    } else {
        PG8_STAGE(PG8_SB(0, 0), cB, voffB); PG8_STAGE(PG8_SA(0, 0), cA, voffA); PG8_STAGE(PG8_SB(0, 1), cB + hstep, voffB); PG8_STAGE(PG8_SA(0, 1), cA + hstep, voffA);
        if (wr == 1) PG8_BAR;
        PG8_WAIT_V(4); PG8_BAR;
        PG8_STAGE(PG8_SB(1, 0), cB + kstep, voffB); PG8_STAGE(PG8_SA(1, 0), cA + kstep, voffA); PG8_STAGE(PG8_SB(1, 1), cB + hstep + kstep, voffB);
        PG8_WAIT_V(6); PG8_BAR;
    }
    for (;;) {
        const bool has_next = S.next(ui + 1, nxt);
        const char* nA = has_next ? (const char*)g.A + (size_t)nxt.pm * tstep : cA; const char* nB = has_next ? (const char*)g.Bt + (size_t)nxt.pn * tstep : cB;
        for (int t = 0; t < nt; t += 2) {
            const bool last = (t == nt - 2);
            const char* a1 = cA + (size_t)(t + 1) * kstep;
            const char* a2 = last ? nA : cA + (size_t)(t + 2) * kstep; const char* b2 = last ? nB : cB + (size_t)(t + 2) * kstep;
            const char* a3 = a2 + kstep; const char* b3 = b2 + kstep;
            if (last && has_next) S.a_ready(nxt);
            if constexpr (SP2) {
            PG8_LDB(B0, 0, 0); PG8_LDB(B1, 0, 1); PG8_SCHED; PG8_LDA(At, 0, 0); PG8_STAGE(PG8_SA(1, 1), a1 + hstep, voffA);
            PG8_WAIT_V(8); PG8_WAIT_L(0); PG8_BAR; PG8_MMA(0, 0, At, B0); PG8_MMA(0, 1, At, B1); PG8_BAR; PG8_SCHED;
            PG8_LDA(At, 0, 1); PG8_STAGE(PG8_SB(0, 0), b2, voffB); PG8_STAGE(PG8_SB(0, 1), b2 + hstep, voffB); PG8_STAGE(PG8_SA(0, 0), a2, voffA);
            PG8_WAIT_V(8); PG8_WAIT_L(0); PG8_BAR; PG8_MMA(1, 0, At, B0); PG8_MMA(1, 1, At, B1); PG8_BAR; PG8_SCHED;
            PG8_LDB(B0, 1, 0); PG8_LDB(B1, 1, 1); PG8_SCHED; PG8_LDA(At, 1, 0); PG8_STAGE(PG8_SA(0, 1), a2 + hstep, voffA);
            PG8_WAIT_V(8); PG8_WAIT_L(0); PG8_BAR; PG8_MMA(0, 0, At, B0); PG8_MMA(0, 1, At, B1); PG8_BAR; PG8_SCHED;
            PG8_LDA(At, 1, 1); PG8_STAGE(PG8_SB(1, 0), b3, voffB); PG8_STAGE(PG8_SB(1, 1), b3 + hstep, voffB); PG8_STAGE(PG8_SA(1, 0), a3, voffA);
            PG8_WAIT_V(8); PG8_WAIT_L(0); PG8_BAR; PG8_MMA(1, 0, At, B0); PG8_MMA(1, 1, At, B1); PG8_BAR; PG8_SCHED;
            } else {
            PG8_LDB(B0, 0, 0); PG8_SCHED; PG8_LDA(At, 0, 0); PG8_STAGE(PG8_SA(1, 1), a1 + hstep, voffA);
            PG8_WAIT_L(8); PG8_BAR; PG8_WAIT_L(0); PG8_MMA(0, 0, At, B0); PG8_BAR; PG8_SCHED;
            PG8_LDB(B1, 0, 1); PG8_STAGE(PG8_SB(0, 0), b2, voffB);
            PG8_BAR; PG8_WAIT_L(0); PG8_MMA(0, 1, At, B1); PG8_BAR;
            PG8_LDA(At, 0, 1); PG8_STAGE(PG8_SA(0, 0), a2, voffA);
            PG8_BAR; PG8_WAIT_L(0); PG8_MMA(1, 0, At, B0); PG8_BAR; PG8_SCHED;
            PG8_STAGE(PG8_SB(0, 1), b2 + hstep, voffB);
            PG8_WAIT_V(6); PG8_BAR; PG8_MMA(1, 1, At, B1); PG8_BAR;
            PG8_LDB(B0, 1, 0); PG8_SCHED; PG8_LDA(At, 1, 0); PG8_STAGE(PG8_SA(0, 1), a2 + hstep, voffA);
            PG8_WAIT_L(8); PG8_BAR; PG8_WAIT_L(0); PG8_MMA(0, 0, At, B0); PG8_BAR; PG8_SCHED;
            PG8_LDB(B1, 1, 1); PG8_STAGE(PG8_SB(1, 0), b3, voffB);
            PG8_BAR; PG8_WAIT_L(0); PG8_MMA(0, 1, At, B1); PG8_BAR;
            PG8_LDA(At, 1, 1); PG8_STAGE(PG8_SA(1, 0), a3, voffA);
            PG8_BAR; PG8_WAIT_L(0); PG8_MMA(1, 0, At, B0); PG8_BAR; PG8_SCHED;
            PG8_STAGE(PG8_SB(1, 1), b3 + hstep, voffB);
            PG8_WAIT_V(6); PG8_BAR; PG8_MMA(1, 1, At, B1); PG8_BAR;
            }
        }
        if constexpr (ALIGN_EPI) { if (wr == 0) PG8_BAR; }
        if constexpr (!Epi::AFTER_DRAIN) { E(acc, cur, wr, wc, fr, fq); S.done(cur); }
        if (!has_next) break;
#pragma unroll
        for (int a = 0; a < 2; ++a)
#pragma unroll
            for (int b = 0; b < 2; ++b)
#pragma unroll
                for (int m = 0; m < 4; ++m)
#pragma unroll
                    for (int n = 0; n < 2; ++n) acc[a][b][m][n] = (f32x4){0.f, 0.f, 0.f, 0.f};
        cur = nxt; cA = nA; cB = nB; ++ui;
        if constexpr (ALIGN_EPI) { if (wr == 1) PG8_BAR; }
    }
    PG8_WAIT_V(0);
    if constexpr (!ALIGN_EPI) { if (wr == 0) PG8_BAR; }
    PG8_BAR;
    if constexpr (Epi::AFTER_DRAIN) { E.fused(acc, cur, wr, wc, fr, fq, lds, wid, lane); S.done(cur); }
#undef PG8_SA
#undef PG8_SB
#undef PG8_STAGE
#undef PG8_LDA
#undef PG8_LDB
#undef PG8_MMA
#undef PG8_WAIT_V
#undef PG8_WAIT_L
#undef PG8_BAR
#undef PG8_SCHED
}
}

#define LAS __attribute__((address_space(3)))
typedef unsigned short bf16;
typedef short bf16x8 __attribute__((ext_vector_type(8)));
typedef short s16x4 __attribute__((ext_vector_type(4)));
typedef float f32x4 __attribute__((ext_vector_type(4)));
typedef float f32x16 __attribute__((ext_vector_type(16)));
typedef float f32x2_t __attribute__((ext_vector_type(2)));
typedef __bf16 bf16x2_t __attribute__((ext_vector_type(2)));
typedef unsigned u32x4 __attribute__((ext_vector_type(4)));
typedef unsigned u32x2 __attribute__((ext_vector_type(2)));

constexpr int M = 16384, DM = 1024, SEQ = 2048, NB = 8, FF = 4096;
constexpr float RMS_EPS = 1e-6f;
constexpr float LOG2E = 1.4426950408889634f;
constexpr int NWAVES = 8, NTHREADS = 512;
constexpr int LDS_BYTES = 147456;

__device__ __forceinline__ unsigned pk2(float lo, float hi) { f32x2_t v = {lo, hi}; return __builtin_bit_cast(unsigned, __builtin_convertvector(v, bf16x2_t)); }
__device__ __forceinline__ float bf2f(unsigned short b) { return __uint_as_float(((unsigned)b) << 16); }
__device__ __forceinline__ int lane_id_here() { int z = 0; asm volatile("" : "+v"(z)); return __builtin_amdgcn_mbcnt_hi(-1, __builtin_amdgcn_mbcnt_lo(-1, z)); }
__device__ __forceinline__ float shfl_idx(float v, int src) { return __int_as_float(__builtin_amdgcn_ds_bpermute(src << 2, __float_as_int(v))); }
__device__ __forceinline__ float shfl_xor_l(float v, int mask, int lane) { return shfl_idx(v, lane ^ mask); }
__device__ __forceinline__ float wave_sum(float v) {
    const int l = lane_id_here();
#pragma unroll
    for (int o = 1; o < 64; o <<= 1) v += shfl_xor_l(v, o, l);
    return v;
}

constexpr size_t MiB = 1u << 20;
constexpr size_t WS_TABP = 1 * MiB;
constexpr size_t WS_TABL = WS_TABP + 2048 * 16 * 4;
constexpr size_t WS_LSE = 2 * MiB;
constexpr size_t WS_W = 4 * MiB;
constexpr size_t W_A_QK = WS_W;
constexpr size_t W_A_V = W_A_QK + 4 * MiB;
constexpr size_t W_A_O = W_A_V + 2 * MiB;
constexpr size_t W_B_IN = W_A_O + 2 * MiB;
constexpr size_t W_B_UQ = W_B_IN + 1 * MiB;
constexpr size_t W_B_K = W_B_UQ + 768 * 1024;
constexpr size_t W_B_V = W_B_K + 256 * 1024;
constexpr size_t W_B_O = W_B_V + 256 * 1024;
constexpr size_t W_C_QK = W_B_O + 2 * MiB;
constexpr size_t W_C_V = W_C_QK + 4 * MiB;
constexpr size_t W_C_O = W_C_V + 2 * MiB;
constexpr size_t W_D_QK = W_C_O + 2 * MiB;
constexpr size_t W_D_V = W_D_QK + 4 * MiB;
constexpr size_t W_D_O = W_D_V + 2 * MiB;
constexpr size_t W_L = W_D_O + 2 * MiB;
constexpr size_t W_L_STRIDE = 8 * MiB + 8 * MiB + 2 * MiB + 512 * 1024;
constexpr size_t W_L_UP = 0, W_L_DOWN = 8 * MiB, W_L_GATE = 16 * MiB, W_L_PROJ = 18 * MiB;
constexpr size_t WS_PB = W_L + 4 * W_L_STRIDE;
constexpr size_t WS_HN = WS_PB + 8 * MiB;
constexpr size_t WS_BIG = WS_HN + 32 * MiB;
constexpr size_t BIG_Q = 0, BIG_K = 48 * MiB, BIG_V = 96 * MiB, BIG_O = 128 * MiB;
constexpr size_t WS_RS = WS_BIG + 160 * MiB;
constexpr size_t WS_END = WS_RS + 3 * MiB;

#define XB_TMO      128
#define XB_XCNT(j)  (256  + 64 * (j))
#define XB_XSUB(j)  (1280 + 64 * (j))
#define XB_XGEN(j)  (2304 + 64 * (j))
#define XB_TOP      3328
#define XB_TOPGEN   3392
#define XCD_BAR_WORDS 3456
#define XB_SPIN_CAP (1u << 18)

__device__ __forceinline__ unsigned xb_ld(unsigned* p)              { return __hip_atomic_load(p, __ATOMIC_RELAXED, __HIP_MEMORY_SCOPE_AGENT); }
__device__ __forceinline__ unsigned xb_add(unsigned* p, unsigned v) { return __hip_atomic_fetch_add(p, v, __ATOMIC_RELAXED, __HIP_MEMORY_SCOPE_AGENT); }
__device__ __forceinline__ unsigned xb_xcc_id() { return (unsigned)__builtin_amdgcn_s_getreg((3 << 11) | 20) & 0xFu; }
#define XB_SPIN(cond, bar) do { unsigned _sp = 0; while (cond) { __builtin_amdgcn_s_sleep(1); \
    if ((++_sp & 255u) == 0u) { if (xb_ld(&(bar)[XB_TMO])) break; if (_sp > XB_SPIN_CAP) { atomicAdd(&(bar)[XB_TMO], 1u); break; } } } } while (0)

struct XcdBarrier {
    unsigned* bar; unsigned x;
    volatile LAS unsigned* st;
};

__device__ __forceinline__ XcdBarrier xcd_barrier_post(unsigned* bar, volatile LAS unsigned* st, bool is_t0) {
    XcdBarrier b; b.bar = bar; b.x = xb_xcc_id(); b.st = st;
    if (is_t0) (void)xb_add(&bar[XB_XCNT(b.x)], 1u);
    return b;
}
__device__ __forceinline__ void xcd_barrier_complete(unsigned* bar, unsigned x, unsigned& nloc, unsigned& nx) {
    const unsigned G = gridDim.x * gridDim.y * gridDim.z;
    unsigned sum, cnt, mine, sp = 0u;
    for (;;) {
        sum = 0u; cnt = 0u; mine = 0u;
#pragma unroll
        for (unsigned j = 0; j < 16; ++j) { const unsigned c = xb_ld(&bar[XB_XCNT(j)]); sum += c; cnt += (c > 0u) ? 1u : 0u; mine = (j == x) ? c : mine; }
        if (sum == G) break;
        __builtin_amdgcn_s_sleep(1);
        if ((++sp & 255u) == 0u) { if (xb_ld(&bar[XB_TMO])) break; if (sp > XB_SPIN_CAP) { atomicAdd(&bar[XB_TMO], 1u); break; } }
    }
    nloc = mine > 0u ? mine : 1u; nx = cnt > 0u ? cnt : 1u;
}

__device__ __forceinline__ void xcd_barrier(const XcdBarrier& b, bool is_t0) {
    asm volatile("s_waitcnt vmcnt(0)" ::: "memory");
    __syncthreads();
    if (is_t0) {
        unsigned* bar = b.bar;
        __builtin_amdgcn_s_waitcnt(0);
        unsigned nloc = b.st[0], nx = b.st[1];
        if (nloc == 0u) { xcd_barrier_complete(bar, b.x, nloc, nx); b.st[0] = nloc; b.st[1] = nx; }
        const unsigned old = xb_add(&bar[XB_XSUB(b.x)], 1u);
        const unsigned gen = old / nloc;
        if (old + 1u == (gen + 1u) * nloc) {
            __builtin_amdgcn_fence(__ATOMIC_RELEASE, "agent");
            asm volatile("s_waitcnt vmcnt(0)" ::: "memory");
            const unsigned og = xb_add(&bar[XB_TOP], 1u);
            const unsigned tg = og / nx;
            if (og + 1u == (tg + 1u) * nx) xb_add(&bar[XB_TOPGEN], 1u);
            else XB_SPIN(xb_ld(&bar[XB_TOPGEN]) == tg, bar);
            __builtin_amdgcn_fence(__ATOMIC_ACQUIRE, "agent");
            xb_add(&bar[XB_XGEN(b.x)], 1u);
            asm volatile("s_waitcnt vmcnt(0)" ::: "memory");
        } else {
            XB_SPIN(xb_ld(&bar[XB_XGEN(b.x)]) == gen, bar);
            __builtin_amdgcn_fence(__ATOMIC_ACQUIRE, "agent");
            asm volatile("s_waitcnt vmcnt(0)" ::: "memory");
        }
    }
    __syncthreads();
}

enum { EPI_QK = 0, EPI_VT, EPI_RESID, EPI_SQRELU, EPI_BF16, EPI_GATE, EPI_F32, EPI_MLAQ };
struct EpiP {
    void* o0; void* o1; const void* aux; const float* tab;
    int ld, qcols, kcols, heads, hstride, rope, dil, dv;
    const float* rs_in;
    float* rs_out;
    bf16* xb_out;
    float qscale;
};
__device__ __forceinline__ int dil_of_head(int head) { return head < 5 ? 1 : (head < 10 ? 4 : 16); }
__device__ __forceinline__ int perm_pos(int s, int dil) { return (s % dil) * (SEQ / dil) + s / dil; }

__device__ __forceinline__ float rowsum16(const float* r) {
    const f32x4 a = *(const f32x4*)r, b = *(const f32x4*)(r + 4), c = *(const f32x4*)(r + 8), d = *(const f32x4*)(r + 12);
    return (((a[0] + a[1]) + (a[2] + a[3])) + ((b[0] + b[1]) + (b[2] + b[3]))) + (((c[0] + c[1]) + (c[2] + c[3])) + ((d[0] + d[1]) + (d[2] + d[3])));
}
template <int MODE> struct Epi {
    static constexpr bool PERM = true, AFTER_DRAIN = false;
    EpiP p;
    struct Pre { f32x4 rs[4]; f32x4 xa[2][2]; u32x4 tw[2]; u32x4 xw[2]; f32x4 tb[4]; };
    __device__ __forceinline__ void prefetch(Pre& q, const pg8::Unit& u, int wr, int wc, int fr, int fq, int ai, int m) const {
        const int row = u.pm * 256 + ai * 128 + wr * 64 + m * 16 + fr;
        if (MODE != EPI_VT && p.rs_in) { const float* r = p.rs_in + (size_t)row * 16;
#pragma unroll
            for (int j = 0; j < 4; ++j) q.rs[j] = *(const f32x4*)(r + 4 * j); }
        if constexpr (MODE == EPI_RESID || MODE == EPI_GATE) {
#pragma unroll
            for (int bj = 0; bj < 2; ++bj) {
                const int col0 = u.pn * 256 + bj * 128 + wc * 32 + 8 * fq;
                if constexpr (MODE == EPI_RESID) {
                    if (p.rope) { const float* bp = (const float*)p.aux + (size_t)row * p.ld + col0; q.xa[bj][0] = *(const f32x4*)bp; q.xa[bj][1] = *(const f32x4*)(bp + 4); }
                    else q.xw[bj] = *(const u32x4*)((const bf16*)p.aux + (size_t)row * p.ld + col0);
                } else {
                    q.xw[bj] = *(const u32x4*)((const bf16*)p.o1 + (size_t)row * p.ld + col0);
                    q.tw[bj] = *(const u32x4*)((const bf16*)p.aux + (size_t)row * p.ld + col0);
                }
            }
        }
        if constexpr (MODE == EPI_QK) { if (p.rope) { const float* t = p.tab + (row & 2047) * 16;
#pragma unroll
            for (int j = 0; j < 4; ++j) q.tb[j] = *(const f32x4*)(t + 4 * j); } }
    }
    __device__ __forceinline__ void operator()(const pg8::f32x4 (&acc)[2][2][4][2], const pg8::Unit& u, int wr, int wc, int fr_in, int fq_in) const {
        const int l_ = lane_id_here(), fr = l_ & 15, fq = l_ >> 4;
        (void)fr_in; (void)fq_in;
        float rst_tok = 1.f;
        if (MODE == EPI_VT && p.rs_in) rst_tok = rsqrtf(rowsum16(p.rs_in + (size_t)(u.pn * 256 + 128 * (l_ >> 5) + 32 * wc + (l_ & 31)) * 16) * (1.f / DM) + RMS_EPS);
        Pre q0; prefetch(q0, u, wr, wc, fr, fq, 0, 0);
#pragma unroll
        for (int step = 0; step < 8; ++step) {
            const int ai = step >> 2, m = step & 3;
            Pre q1; if (step < 7) prefetch(q1, u, wr, wc, fr, fq, (step + 1) >> 2, (step + 1) & 3);
            {
                const int row = u.pm * 256 + ai * 128 + wr * 64 + m * 16 + fr;
                float rstd = 1.f;
                if (MODE != EPI_VT && p.rs_in) { const f32x4 a = q0.rs[0], b = q0.rs[1], c = q0.rs[2], d = q0.rs[3];
                    rstd = rsqrtf(((((a[0] + a[1]) + (a[2] + a[3])) + ((b[0] + b[1]) + (b[2] + b[3]))) + (((c[0] + c[1]) + (c[2] + c[3])) + ((d[0] + d[1]) + (d[2] + d[3])))) * (1.f / DM) + RMS_EPS); }
                float ss = 0.f;
#pragma unroll
                for (int bj = 0; bj < 2; ++bj) {
                    const int col0 = u.pn * 256 + bj * 128 + wc * 32 + 8 * fq;
                    float v[8];
#pragma unroll
                    for (int j = 0; j < 4; ++j) { v[j] = acc[ai][bj][m][0][j] * rstd; v[4 + j] = acc[ai][bj][m][1][j] * rstd; }
                    if (MODE == EPI_VT && p.rs_in) {
#pragma unroll
                        for (int j = 0; j < 8; ++j) v[j] *= shfl_idx(rst_tok, bj * 32 + 8 * fq + j);
                    }
                    if constexpr (MODE == EPI_QK) {
                        const int b = row >> 11, s = row & 2047;
                        if (col0 < p.qcols) {
#pragma unroll
                            for (int j = 0; j < 8; ++j) v[j] *= p.qscale;
                        }
                        if (p.rope) {
                            float pr[8];
                            { const int ll = l_ ^ 16;
#pragma unroll
                            for (int j = 0; j < 8; ++j) pr[j] = shfl_idx(v[j], ll); }
                            const int d0 = col0 & 63;
                            if (d0 < 16) {
                                const f32x4 c0 = q0.tb[0], c1 = q0.tb[1], s0 = q0.tb[2], s1 = q0.tb[3];
                                const float sg = (d0 == 0) ? -1.f : 1.f;
#pragma unroll
                                for (int j = 0; j < 4; ++j) { v[j] = v[j] * c0[j] + sg * pr[j] * s0[j]; v[4 + j] = v[4 + j] * c1[j] + sg * pr[4 + j] * s1[j]; }
                            }
                        }
                        if (col0 < p.qcols + p.kcols) {
                            const bool isk = col0 >= p.qcols; const int cc = isk ? col0 - p.qcols : col0;
                            const int head = cc >> 6, d0 = cc & 63;
                            int pos = s; if (p.dil) pos = perm_pos(s, dil_of_head(head));
                            bf16* dst = (bf16*)(isk ? p.o1 : p.o0) + ((size_t)(b * p.heads + head) * SEQ + pos) * p.hstride + d0;
                            u32x4 w; w.x = pk2(v[0], v[1]); w.y = pk2(v[2], v[3]); w.z = pk2(v[4], v[5]); w.w = pk2(v[6], v[7]);
                            *(u32x4*)dst = w;
                        }
                    } else if constexpr (MODE == EPI_MLAQ) {
                        const int b = row >> 11, s = row & 2047;
#pragma unroll
                        for (int j = 0; j < 8; ++j) v[j] *= p.qscale;
                        float pr[8];
                        { const int ll = l_ ^ 32;
#pragma unroll
                        for (int j = 0; j < 8; ++j) pr[j] = shfl_idx(v[j], ll); }
                        if (col0 < 1536) {
                            const int head = col0 / 96, w0 = col0 - head * 96;
                            if (w0 >= 64) {
                                const int jj = w0 - 64; const float* t = p.tab + s * 32;
                                const int jb = jj & 15; const float sg = (jj < 16) ? -1.f : 1.f;
                                const f32x4 c0 = *(const f32x4*)(t + jb), c1 = *(const f32x4*)(t + jb + 4), s0 = *(const f32x4*)(t + 16 + jb), s1 = *(const f32x4*)(t + 16 + jb + 4);
#pragma unroll
                                for (int j = 0; j < 4; ++j) { v[j] = v[j] * c0[j] + sg * pr[j] * s0[j]; v[4 + j] = v[4 + j] * c1[j] + sg * pr[4 + j] * s1[j]; }
                            }
                            bf16* dst = (bf16*)p.o0 + ((size_t)(b * 16 + head) * SEQ + s) * 96 + w0;
                            u32x4 w; w.x = pk2(v[0], v[1]); w.y = pk2(v[2], v[3]); w.z = pk2(v[4], v[5]); w.w = pk2(v[6], v[7]);
                            *(u32x4*)dst = w;
                        }
                    } else if constexpr (MODE == EPI_VT) {
                        if (row < p.qcols) {
                            const int head = row / p.dv, d = row - head * p.dv;
                            const int b = col0 >> 11, s0 = col0 & 2047;
                            bf16* base = (bf16*)p.o0 + (size_t)(b * p.heads + head) * p.dv * SEQ + (size_t)d * 64;
                            const int dil = p.dil ? dil_of_head(head) : 1;
                            if (dil == 1) {
                                u32x4 w; w.x = pk2(v[0], v[1]); w.y = pk2(v[2], v[3]); w.z = pk2(v[4], v[5]); w.w = pk2(v[6], v[7]);
                                *(u32x4*)(base + (size_t)(s0 >> 6) * (p.dv * 64) + (s0 & 63)) = w;
                            } else {
#pragma unroll
                                for (int j = 0; j < 8; ++j) { const int pp = perm_pos(s0 + j, dil); base[(size_t)(pp >> 6) * (p.dv * 64) + (pp & 63)] = (bf16)(pk2(v[j], 0.f) & 0xffffu); }
                            }
                        }
                    } else if constexpr (MODE == EPI_RESID) {
                        if (p.rope) { const f32x4 b0 = q0.xa[bj][0], b1 = q0.xa[bj][1];
#pragma unroll
                            for (int j = 0; j < 4; ++j) { v[j] += b0[j]; v[4 + j] += b1[j]; }
                        } else { const u32x4 xw = q0.xw[bj];
                            v[0] += __uint_as_float(xw.x << 16); v[1] += __uint_as_float(xw.x & 0xffff0000u); v[2] += __uint_as_float(xw.y << 16); v[3] += __uint_as_float(xw.y & 0xffff0000u);
                            v[4] += __uint_as_float(xw.z << 16); v[5] += __uint_as_float(xw.z & 0xffff0000u); v[6] += __uint_as_float(xw.w << 16); v[7] += __uint_as_float(xw.w & 0xffff0000u); }
                        if (p.xb_out) {
                            u32x4 w; w.x = pk2(v[0], v[1]); w.y = pk2(v[2], v[3]); w.z = pk2(v[4], v[5]); w.w = pk2(v[6], v[7]);
                            *(u32x4*)(p.xb_out + (size_t)row * p.ld + col0) = w;
#pragma unroll
                            for (int j = 0; j < 8; ++j) ss += v[j] * v[j];
                        }
                    } else if constexpr (MODE == EPI_SQRELU) {
#pragma unroll
                        for (int j = 0; j < 8; ++j) { const float r = fmaxf(v[j], 0.f); v[j] = r * r; }
                        u32x4 w; w.x = pk2(v[0], v[1]); w.y = pk2(v[2], v[3]); w.z = pk2(v[4], v[5]); w.w = pk2(v[6], v[7]);
                        *(u32x4*)((bf16*)p.o0 + (size_t)row * p.ld + col0) = w;
                    } else if constexpr (MODE == EPI_BF16) {
                        u32x4 w; w.x = pk2(v[0], v[1]); w.y = pk2(v[2], v[3]); w.z = pk2(v[4], v[5]); w.w = pk2(v[6], v[7]);
                        *(u32x4*)((bf16*)p.o0 + (size_t)row * p.ld + col0) = w;
                    } else if constexpr (MODE == EPI_GATE) {
                        const u32x4 tw = q0.tw[bj], xw = q0.xw[bj];
                        float t[8];
                        t[0] = __uint_as_float(tw.x << 16); t[1] = __uint_as_float(tw.x & 0xffff0000u); t[2] = __uint_as_float(tw.y << 16); t[3] = __uint_as_float(tw.y & 0xffff0000u);
                        t[4] = __uint_as_float(tw.z << 16); t[5] = __uint_as_float(tw.z & 0xffff0000u); t[6] = __uint_as_float(tw.w << 16); t[7] = __uint_as_float(tw.w & 0xffff0000u);
                        f32x4 x0 = {__uint_as_float(xw.x << 16), __uint_as_float(xw.x & 0xffff0000u), __uint_as_float(xw.y << 16), __uint_as_float(xw.y & 0xffff0000u)};
                        f32x4 x1 = {__uint_as_float(xw.z << 16), __uint_as_float(xw.z & 0xffff0000u), __uint_as_float(xw.w << 16), __uint_as_float(xw.w & 0xffff0000u)};
#pragma unroll
                        for (int j = 0; j < 4; ++j) { x0[j] += t[j] / (1.f + __expf(-v[j])); x1[j] += t[4 + j] / (1.f + __expf(-v[4 + j])); }
                        if (p.xb_out) {
                            u32x4 w; w.x = pk2(x0[0], x0[1]); w.y = pk2(x0[2], x0[3]); w.z = pk2(x1[0], x1[1]); w.w = pk2(x1[2], x1[3]);
                            *(u32x4*)(p.xb_out + (size_t)row * p.ld + col0) = w;
#pragma unroll
                            for (int j = 0; j < 4; ++j) ss += x0[j] * x0[j] + x1[j] * x1[j];
                        }
                    } else if constexpr (MODE == EPI_F32) {
                        float* op = (float*)p.o0 + (size_t)row * p.ld + col0;
                        *(f32x4*)op = (f32x4){v[0], v[1], v[2], v[3]}; *(f32x4*)(op + 4) = (f32x4){v[4], v[5], v[6], v[7]};
                    }
                }
                if ((MODE == EPI_RESID || MODE == EPI_GATE) && p.rs_out) {
                    ss += shfl_idx(ss, l_ ^ 16); ss += shfl_idx(ss, l_ ^ 32);
                    if (fq == 0) p.rs_out[(size_t)row * 16 + u.pn * 4 + wc] = ss;
                }
            }
            asm volatile("" ::: "memory");
            q0 = q1;
        }
    }
};

template <int MODE>
__device__ __forceinline__ void run_gemm_(LAS unsigned char* lds, const bf16* A, const bf16* Bt, int Mr, int Nc, int K, const EpiP& ep, int wave_s) {
    const int tid = wave_s * 64 + lane_id_here();
    int bx = blockIdx.x, gx = gridDim.x; asm volatile("" : "+s"(bx), "+s"(gx));
    pg8::Gemm g{A, Bt, Mr, Nc, K}; pg8::StaticOrder S; S.init(Mr, Nc, gx, bx);
    Epi<MODE> E{ep};
    pg8::gemm_phase<Epi<MODE>, pg8::StaticOrder, true, true>(lds, g, S, E, tid);
}


struct AttnP {
    const bf16* Q; const bf16* K; const bf16* Vt; bf16* O; float* lse;
    const float* rpb; const float* lq1; const float* lk1; const float* lq2; const float* lk2; const float* subln;
    float* stash; float lambda_init; int pad;
};
#define GAS __attribute__((address_space(1)))
__device__ __forceinline__ float vmax3(float a, float b, float c) { float r; asm("v_max3_f32 %0, %1, %2, %3" : "=v"(r) : "v"(a), "v"(b), "v"(c)); return r; }
__device__ __forceinline__ float vmax16(float m, const f32x16& s) {
    asm("v_max3_f32 %0, %1, %2, %0\n\tv_max3_f32 %0, %3, %4, %0\n\tv_max3_f32 %0, %5, %6, %0\n\tv_max3_f32 %0, %7, %8, %0\n\t"
        "v_max3_f32 %0, %9, %10, %0\n\tv_max3_f32 %0, %11, %12, %0\n\tv_max3_f32 %0, %13, %14, %0\n\tv_max3_f32 %0, %15, %16, %0"
        : "+v"(m) : "v"(s[0]), "v"(s[1]), "v"(s[2]), "v"(s[3]), "v"(s[4]), "v"(s[5]), "v"(s[6]), "v"(s[7]), "v"(s[8]), "v"(s[9]), "v"(s[10]), "v"(s[11]), "v"(s[12]), "v"(s[13]), "v"(s[14]), "v"(s[15]));
    return m;
}
__device__ __forceinline__ float halfmax3(float m_other, float x) {
    const auto r = __builtin_amdgcn_permlane32_swap(__float_as_uint(x), __float_as_uint(x), false, false);
    return vmax3(m_other, __uint_as_float(r[0]), __uint_as_float(r[1]));
}
#define MFMA32(a, b, c) __builtin_amdgcn_mfma_f32_32x32x16_bf16((a), (b), (c), 0, 0, 0)

template <int MODE>
__device__ __forceinline__ void attn_phase_(LAS unsigned char* lds, const AttnP& P, const int tid_in) {
    constexpr int DQ = (MODE == 1) ? 96 : 64, DV = (MODE == 3) ? 128 : 64;
    constexpr int H = (MODE == 0) ? 15 : (MODE == 3 ? 8 : 16);
    constexpr int HQ = (MODE == 3) ? 16 : H;
    constexpr int NPASS = (MODE == 3) ? 2 : 1;
    constexpr int KROW = DQ * 2 + 16, VROW = 136;
    constexpr int NKS = DQ / 16, NDB = DV / 32;
    constexpr int KCH = 64 * (DQ / 8);
    constexpr int VCH = DV * 8;
    constexpr int NU = NB * H * 8;
    constexpr int KBUF = 64 * KROW, VBUF = DV * VROW;
    constexpr int K_OFF = 0, V_OFF = 2 * 13312, B_OFF = V_OFF + 2 * 17408;
    static_assert(KBUF <= 13312 && VBUF <= 17408, "attention LDS map");
    int tid_o = tid_in; asm volatile("" : "+v"(tid_o));
    const int tid = tid_o, lane = tid & 63, wave = __builtin_amdgcn_readfirstlane(tid >> 6), r32 = lane & 31, h = lane >> 5;
    LAS float* ldsB = (LAS float*)(lds + B_OFF);

    float lam = 0.f;
    if constexpr (MODE == 3) {
        const float a1 = wave_sum(P.lq1[lane] * P.lk1[lane]), a2 = wave_sum(P.lq2[lane] * P.lk2[lane]);
        lam = __expf(a1) - __expf(a2) + P.lambda_init;
    }

    int bx = blockIdx.x, gx = gridDim.x; asm volatile("" : "+s"(bx), "+s"(gx));
    const bool xmap = (gx & 7) == 0; const int xcd = bx & 7, nslot = gx >> 3;
    for (int it = xmap ? (bx >> 3) : bx; ; it += xmap ? nslot : gx) {
        int unit;
        if (xmap) { const int bh_ = (it >> 3) * 8 + xcd; if (bh_ >= NB * H) break; unit = bh_ * 8 + (it & 7); } else { if (it >= NU) break; unit = it; }
        const int qb = unit & 7, bh = unit >> 3, head = bh % H, b = bh / H;
        int kt_lo = 0, kt_hi = 32;
        if constexpr (MODE == 0) { kt_lo = max(0, qb * 4 - 1); kt_hi = min(32, qb * 4 + 5); }
        if constexpr (MODE == 2) { const int r0 = qb * 4; kt_lo = min(max(r0 - 4, 0), 24); kt_hi = min(max(r0 - 1, 0), 24) + 8; }
        const int wq0 = qb * 256 + wave * 32, qpos = wq0 + r32;
        int dil = 1, L = SEQ;
        if constexpr (MODE == 0) { dil = dil_of_head(head); L = SEQ / dil; }
        int qr = 0, qc = 0, rs = 0, win0 = 0;
        if constexpr (MODE == 2) { qr = qpos >> 6; qc = qpos & 63; rs = min(max(qr - 4, 0), 24); win0 = min(max(qc - 8, 0), 48); }
        if constexpr (MODE == 2) {
            __syncthreads();
            for (int i = tid; i < 15 * 31; i += NTHREADS) ldsB[i] = P.rpb[head * 465 + i] * LOG2E;
        }
#pragma nounroll
        for (int pass = 0; pass < NPASS; ++pass) {
            const int hq = (MODE == 3) ? 2 * head + pass : head;
            const bf16* Qp = P.Q + (size_t)(b * HQ + hq) * SEQ * DQ;
            const bf16* Kp = P.K + (size_t)(b * HQ + hq) * SEQ * DQ;
            const bf16* Vp = P.Vt + (size_t)(b * H + head) * DV * SEQ;
            bf16x8 qf[NKS];
#pragma unroll
            for (int ks = 0; ks < NKS; ++ks) qf[ks] = *(const GAS bf16x8*)(Qp + (size_t)qpos * DQ + ks * 16 + h * 8);
            f32x16 O[NDB];
#pragma unroll
            for (int db = 0; db < NDB; ++db)
#pragma unroll
                for (int i = 0; i < 16; ++i) O[db][i] = 0.f;
            float mrun = -1e30f, lsum = 0.f;
            u32x4 kreg0, kreg1, vreg0, vreg1;
            const int kc0 = tid, kc1 = tid + 512;
            const int kr0 = kc0 / (DQ / 8), kcc0 = kc0 % (DQ / 8), kr1 = kc1 / (DQ / 8), kcc1 = kc1 % (DQ / 8);
            const int vd0 = tid >> 3, vcc = tid & 7, vd1 = vd0 + 64;
#define GLOAD_K(kt_) do { const bf16* kb = Kp + (size_t)(kt_) * 64 * DQ; \
                kreg0 = *(const GAS u32x4*)(kb + kr0 * DQ + kcc0 * 8); \
                if (KCH > 512 && kc1 < KCH) kreg1 = *(const GAS u32x4*)(kb + kr1 * DQ + kcc1 * 8); } while (0)
#define GLOAD_V(kt_) do { const bf16* vb = Vp + (size_t)(kt_) * (DV * 64);     \
                vreg0 = *(const GAS u32x4*)(vb + vd0 * 64 + vcc * 8); \
                if (VCH > 512) vreg1 = *(const GAS u32x4*)(vb + vd1 * 64 + vcc * 8); } while (0)
#define LSTORE_K(buf_) do { LAS unsigned char* kB = lds + K_OFF + (buf_) * 13312; \
                *(LAS u32x4*)(kB + kr0 * KROW + kcc0 * 16) = kreg0; \
                if (KCH > 512 && kc1 < KCH) *(LAS u32x4*)(kB + kr1 * KROW + kcc1 * 16) = kreg1; } while (0)
#define LSTORE_V(buf_) do { LAS unsigned char* vB = lds + V_OFF + (buf_) * 17408; \
                { LAS unsigned char* vp = vB + vd0 * VROW + vcc * 16; *(LAS u32x2*)vp = (u32x2){vreg0.x, vreg0.y}; *(LAS u32x2*)(vp + 8) = (u32x2){vreg0.z, vreg0.w}; } \
                if (VCH > 512) { LAS unsigned char* vp = vB + vd1 * VROW + vcc * 16; *(LAS u32x2*)vp = (u32x2){vreg1.x, vreg1.y}; *(LAS u32x2*)(vp + 8) = (u32x2){vreg1.z, vreg1.w}; } } while (0)
#define QK_TILE(S0_, S1_, kb_) do { const LAS unsigned char* ldsK = lds + K_OFF + (kb_) * 13312; \
                _Pragma("unroll") for (int i = 0; i < 16; ++i) { S0_[i] = 0.f; S1_[i] = 0.f; } \
                _Pragma("unroll") for (int ks = 0; ks < NKS; ++ks) { \
                    const bf16x8 a0 = *(const LAS bf16x8*)(ldsK + r32 * KROW + ks * 32 + h * 16); \
                    const bf16x8 a1 = *(const LAS bf16x8*)(ldsK + (32 + r32) * KROW + ks * 32 + h * 16); \
                    S0_ = MFMA32(a0, qf[ks], S0_); S1_ = MFMA32(a1, qf[ks], S1_); } } while (0)
#define TILE_SKIP(kt_) ((MODE == 0) ? (((kt_) * 64 > wq0 + 95) || ((kt_) * 64 + 63 < wq0 - 64) || (((kt_) * 64) / L != wq0 / L)) : \
                        (MODE == 2) ? (((kt_) < rs_u) || ((kt_) >= rs_u + 8)) : false)
            const int rs_u = (MODE == 2) ? __builtin_amdgcn_readfirstlane(rs) : 0;
            GLOAD_K(kt_lo); GLOAD_V(kt_lo);
            __syncthreads();
            LSTORE_K(0); LSTORE_V(0);
            if (kt_lo + 1 < kt_hi) GLOAD_K(kt_lo + 1);
            __syncthreads();
            f32x16 s0, s1;
#pragma unroll
            for (int i = 0; i < 16; ++i) { s0[i] = 0.f; s1[i] = 0.f; }
            if (!TILE_SKIP(kt_lo)) QK_TILE(s0, s1, 0);
            if (kt_lo + 1 < kt_hi) { LSTORE_K(1); GLOAD_V(kt_lo + 1); if (kt_lo + 2 < kt_hi) GLOAD_K(kt_lo + 2); }
            __syncthreads();
            for (int kt = kt_lo; kt < kt_hi; ++kt) {
                const int j = kt - kt_lo;
                const LAS unsigned char* ldsV = lds + V_OFF + (j & 1) * 17408;
                const LAS unsigned char* ldsKn = lds + K_OFF + ((j + 1) & 1) * 13312;
                const int key0 = kt * 64;
                constexpr bool DENSE = (MODE == 1 || MODE == 3);
                const bool do_cur = DENSE ? true : !TILE_SKIP(kt), do_nxt = DENSE ? true : ((kt + 1 < kt_hi) && !TILE_SKIP(kt + 1));
                constexpr int KPRE = (MODE == 1) ? NKS : ((MODE == 3) ? 0 : 2), VPRE = (NDB > 2) ? 1 : 2;
                bf16x8 kf[KPRE > 0 ? KPRE : 1][2]; u32x4 vf[VPRE > 0 ? VPRE : 1][NDB];
#define KFRAG(ks_, hf_) (*(const LAS bf16x8*)(ldsKn + ((hf_) * 32 + r32) * KROW + (ks_) * 32 + h * 16))
                if (do_nxt) {
#pragma unroll
                    for (int ks = 0; ks < KPRE; ++ks) { kf[ks][0] = KFRAG(ks, 0); kf[ks][1] = KFRAG(ks, 1); }
                }
#define VFRAG(c_, db_) ({ const LAS unsigned char* vp_ = ldsV + ((db_) * 32 + r32) * VROW + ((c_) * 16 + 4 * h) * 2; \
                          const u32x2 lo_ = *(const LAS u32x2*)vp_, hi_ = *(const LAS u32x2*)(vp_ + 16); (u32x4){lo_.x, lo_.y, hi_.x, hi_.y}; })
                if (do_cur) {
#pragma unroll
                    for (int c = 0; c < VPRE; ++c)
#pragma unroll
                        for (int db = 0; db < NDB; ++db) vf[c][db] = VFRAG(c, db);
                }
                __builtin_amdgcn_sched_barrier(0);
                u32x4 pw[4];
                if (do_cur) {
                    float mx = -INFINITY;
#pragma unroll
                    for (int i = 0; i < 16; ++i) {
                        float v0 = s0[i], v1 = s1[i];
                        if constexpr (MODE == 0) {
                            const int kl = (i & 3) + 8 * (i >> 2) + 4 * h;
                            const int d0 = qpos - (key0 + kl), d1 = d0 - 32;
                            if (d0 > 64 || d0 < -64) v0 = -INFINITY;
                            if (d1 > 64 || d1 < -64) v1 = -INFINITY;
                        }
                        if constexpr (MODE == 2) {
                            const int kl = (i & 3) + 8 * (i >> 2) + 4 * h;
                            const int c0 = kl, c1 = kl + 32; const int rb = (kt - qr + 7) * 31 + 15 - qc;
                            v0 = (c0 >= win0 && c0 < win0 + 16) ? v0 + ldsB[rb + c0] : -INFINITY;
                            v1 = (c1 >= win0 && c1 < win0 + 16) ? v1 + ldsB[rb + c1] : -INFINITY;
                        }
                        s0[i] = v0; s1[i] = v1;
                    }
                    mx = vmax16(vmax16(mx, s0), s1);
                    const float mnew = halfmax3(mrun, mx);
                    if (__builtin_amdgcn_ballot_w64(mnew > mrun + 8.f) != 0ull) {
                        const float alpha = __builtin_amdgcn_exp2f(mrun - mnew);
                        lsum *= alpha;
#pragma unroll
                        for (int db = 0; db < NDB; ++db)
#pragma unroll
                            for (int i = 0; i < 16; ++i) O[db][i] *= alpha;
                        mrun = mnew;
                    }
                }
                f32x16 n0, n1;
#pragma unroll
                for (int i = 0; i < 16; ++i) { n0[i] = 0.f; n1[i] = 0.f; }
                if (do_nxt) {
#pragma unroll
                    for (int ks = 0; ks < KPRE; ++ks) { n0 = MFMA32(kf[ks][0], qf[ks], n0); n1 = MFMA32(kf[ks][1], qf[ks], n1); }
#pragma unroll
                    for (int ks = KPRE; ks < NKS; ++ks) { const bf16x8 a0 = KFRAG(ks, 0), a1 = KFRAG(ks, 1); n0 = MFMA32(a0, qf[ks], n0); n1 = MFMA32(a1, qf[ks], n1); }
                }
                if (do_cur) {
                    float rsum = 0.f;
#pragma unroll
                    for (int i = 0; i < 16; ++i) { s0[i] = __builtin_amdgcn_exp2f(s0[i] - mrun); s1[i] = __builtin_amdgcn_exp2f(s1[i] - mrun); rsum += s0[i] + s1[i]; }
                    lsum += rsum;
                    pw[0] = (u32x4){pk2(s0[0], s0[1]), pk2(s0[2], s0[3]), pk2(s0[4], s0[5]), pk2(s0[6], s0[7])};
                    pw[1] = (u32x4){pk2(s0[8], s0[9]), pk2(s0[10], s0[11]), pk2(s0[12], s0[13]), pk2(s0[14], s0[15])};
                    pw[2] = (u32x4){pk2(s1[0], s1[1]), pk2(s1[2], s1[3]), pk2(s1[4], s1[5]), pk2(s1[6], s1[7])};
                    pw[3] = (u32x4){pk2(s1[8], s1[9]), pk2(s1[10], s1[11]), pk2(s1[12], s1[13]), pk2(s1[14], s1[15])};
                }
                if constexpr (MODE == 1) {
#pragma unroll
                    for (int g = 0; g < 2 * NKS; ++g) { __builtin_amdgcn_sched_group_barrier(0x008, 1, 0); __builtin_amdgcn_sched_group_barrier(0x002, 7, 0); }
                }
                if (do_cur) {
#pragma unroll
                    for (int c = 0; c < VPRE; ++c)
#pragma unroll
                        for (int db = 0; db < NDB; ++db) O[db] = MFMA32(__builtin_bit_cast(bf16x8, vf[c][db]), __builtin_bit_cast(bf16x8, pw[c]), O[db]);
#pragma unroll
                    for (int c = VPRE; c < 4; ++c) {
                        u32x4 vg[NDB];
#pragma unroll
                        for (int db = 0; db < NDB; ++db) vg[db] = VFRAG(c, db);
#pragma unroll
                        for (int db = 0; db < NDB; ++db) O[db] = MFMA32(__builtin_bit_cast(bf16x8, vg[db]), __builtin_bit_cast(bf16x8, pw[c]), O[db]);
                    }
                }
#undef VFRAG
#undef KFRAG
                s0 = n0; s1 = n1;
                if (kt + 2 < kt_hi) LSTORE_K(j & 1);
                if (kt + 1 < kt_hi) LSTORE_V((j + 1) & 1);
                if (kt + 3 < kt_hi) GLOAD_K(kt + 3);
                if (kt + 2 < kt_hi) GLOAD_V(kt + 2);
                asm volatile("s_waitcnt lgkmcnt(0)" ::: "memory"); __builtin_amdgcn_s_barrier(); asm volatile("" ::: "memory");
            }
            const float ltot = lsum + shfl_idx(lsum, lane ^ 32), inv = 1.f / ltot;
#pragma unroll
            for (int db = 0; db < NDB; ++db)
#pragma unroll
                for (int i = 0; i < 16; ++i) O[db][i] *= inv;
            if constexpr (MODE == 3) {
                f32x4* stp = (f32x4*)(P.stash + ((size_t)bx * NTHREADS + tid) * 64);
                if (pass == 0) {
#pragma unroll
                    for (int db = 0; db < NDB; ++db)
#pragma unroll
                        for (int g = 0; g < 4; ++g) stp[db * 4 + g] = (f32x4){O[db][4 * g], O[db][4 * g + 1], O[db][4 * g + 2], O[db][4 * g + 3]};
                } else {
                    float ss = 0.f;
#pragma unroll
                    for (int db = 0; db < NDB; ++db) {
#pragma unroll
                        for (int g = 0; g < 4; ++g) { const f32x4 st = stp[db * 4 + g];
#pragma unroll
                            for (int j = 0; j < 4; ++j) { const float o = st[j] - lam * O[db][4 * g + j]; O[db][4 * g + j] = o; ss += o * o; } }
                        asm volatile("" ::: "memory");
                    }
                    ss += shfl_idx(ss, lane ^ 32);
                    const float rstd = rsqrtf(ss * (1.f / 128.f) + RMS_EPS) * (1.f - P.lambda_init);
                    bf16* orow = P.O + (size_t)(b * SEQ + qpos) * DM + head * 128;
#pragma unroll
                    for (int db = 0; db < NDB; ++db)
#pragma unroll
                        for (int g = 0; g < 4; ++g) {
                            const int d = db * 32 + 8 * g + 4 * h;
                            const f32x4 gn = *(const f32x4*)(P.subln + d);
                            u32x2 w; w.x = pk2(O[db][4 * g] * rstd * gn[0], O[db][4 * g + 1] * rstd * gn[1]); w.y = pk2(O[db][4 * g + 2] * rstd * gn[2], O[db][4 * g + 3] * rstd * gn[3]);
                            *(u32x2*)(orow + d) = w;
                        }
                }
            } else {
                int tok = qpos;
                if constexpr (MODE == 0) tok = (qpos % L) * dil + qpos / L;
                bf16* orow = P.O + (size_t)(b * SEQ + tok) * DM + head * 64;
#pragma unroll
                for (int db = 0; db < NDB; ++db)
#pragma unroll
                    for (int g = 0; g < 4; ++g) {
                        const int d = db * 32 + 8 * g + 4 * h;
                        u32x2 w; w.x = pk2(O[db][4 * g], O[db][4 * g + 1]); w.y = pk2(O[db][4 * g + 2], O[db][4 * g + 3]);
                        *(u32x2*)(orow + d) = w;
                    }
                if constexpr (MODE == 0) { if (h == 0) P.lse[(size_t)head * M + b * SEQ + tok] = mrun * (1.f / LOG2E) + __logf(ltot); }
            }
        }
    }
    __syncthreads();
#undef GLOAD_K
#undef GLOAD_V
#undef LSTORE_K
#undef LSTORE_V
#undef QK_TILE
#undef TILE_SKIP
}

__device__ __forceinline__ void tr_item(const float* W, int ldw, int col0, bf16* WT, int ldt, int row0, int k0, int n0, LAS float* scr, int lane, const float* gain) {
    const int c = lane & 7;
    f32x4 g0 = {1.f, 1.f, 1.f, 1.f}, g1 = g0;
    if (gain) { g0 = *(const f32x4*)(gain + k0 + 8 * c); g1 = *(const f32x4*)(gain + k0 + 8 * c + 4); }
    float wv[32];
    const float* wp = W + (size_t)(k0 + (lane >> 5)) * ldw + col0 + n0 + (lane & 31);
#pragma unroll
    for (int i = 0; i < 32; ++i) wv[i] = wp[(size_t)(2 * i) * ldw];
#pragma unroll
    for (int i = 0; i < 32; ++i) scr[(2 * i + (lane >> 5)) * 33 + (lane & 31)] = wv[i];
    asm volatile("s_waitcnt lgkmcnt(0)" ::: "memory");
#pragma unroll
    for (int j = 0; j < 4; ++j) { const int n = (lane >> 3) + 8 * j; const LAS float* s = scr + (8 * c) * 33 + n;
        u32x4 o; o.x = pk2(s[0 * 33] * g0[0], s[1 * 33] * g0[1]); o.y = pk2(s[2 * 33] * g0[2], s[3 * 33] * g0[3]); o.z = pk2(s[4 * 33] * g1[0], s[5 * 33] * g1[1]); o.w = pk2(s[6 * 33] * g1[2], s[7 * 33] * g1[3]);
        *(u32x4*)(WT + (size_t)(row0 + n0 + n) * ldt + k0 + 8 * c) = o; }
    asm volatile("s_waitcnt lgkmcnt(0)" ::: "memory");
}
__device__ __forceinline__ void tr_job(const float* W, int ldw, int col0, int ncols, int K, bf16* WT, int ldt, int row0, LAS float* scr, int lane, int gw, int ngw, const float* gain) {
    const int nblk = ncols / 32, nitems = (K / 64) * nblk;
    for (int it = gw; it < nitems; it += ngw) { const int kb = it / nblk, nb = it - kb * nblk; tr_item(W, ldw, col0, WT, ldt, row0, 64 * kb, 32 * nb, scr, lane, gain); }
}
__device__ __forceinline__ void rms_row_to_bf16(const float* xrow, const float* g, bf16* orow, int lane) {
    const f32x4* xr = (const f32x4*)xrow + lane; const f32x4* gr = (const f32x4*)g + lane;
    f32x4 v[4]; float s = 0.f;
#pragma unroll
    for (int j = 0; j < 4; ++j) { v[j] = xr[64 * j]; s += (v[j].x * v[j].x + v[j].y * v[j].y) + (v[j].z * v[j].z + v[j].w * v[j].w); }
    const float rstd = rsqrtf(wave_sum(s) * (1.f / DM) + RMS_EPS);
    unsigned long long* o8 = (unsigned long long*)orow + lane;
#pragma unroll
    for (int j = 0; j < 4; ++j) { const f32x4 gg = gr[64 * j];
        o8[64 * j] = (unsigned long long)pk2(v[j].x * rstd * gg.x, v[j].y * rstd * gg.y) | ((unsigned long long)pk2(v[j].z * rstd * gg.z, v[j].w * rstd * gg.w) << 32); }
}
__device__ __forceinline__ void norm_pass(const float* X, const float* g, bf16* HN, int lane, int gw, int ngw) {
    for (int m = gw; m < M; m += ngw) rms_row_to_bf16(X + (size_t)m * DM, g, HN + (size_t)m * DM, lane);
}
__device__ __forceinline__ void pconv_pass(const float* Pf, bf16* PB, int lane, int gw, int ngw) {
    for (int m = gw; m < M; m += ngw) { const f32x4 v = *((const f32x4*)(Pf + (size_t)m * 256) + lane);
        *((u32x2*)(PB + (size_t)m * 256) + lane) = (u32x2){pk2(v.x, v.y), pk2(v.z, v.w)}; }
}
__device__ __forceinline__ void final_norm_pass(float* X, const float* g, int lane, int gw, int ngw) {
    for (int m = gw; m < M; m += ngw) {
        f32x4* xr = (f32x4*)(X + (size_t)m * DM) + lane; const f32x4* gr = (const f32x4*)g + lane;
        f32x4 v[4]; float s = 0.f;
#pragma unroll
        for (int j = 0; j < 4; ++j) { v[j] = xr[64 * j]; s += (v[j].x * v[j].x + v[j].y * v[j].y) + (v[j].z * v[j].z + v[j].w * v[j].w); }
        const float rstd = rsqrtf(wave_sum(s) * (1.f / DM) + RMS_EPS);
#pragma unroll
        for (int j = 0; j < 4; ++j) { const f32x4 gg = gr[64 * j]; xr[64 * j] = (f32x4){v[j].x * rstd * gg.x, v[j].y * rstd * gg.y, v[j].z * rstd * gg.z, v[j].w * rstd * gg.w}; }
    }
}
__device__ __forceinline__ void mix_pass(bf16* O, const float* lse, int lane, int gw, int ngw) {
    for (int m = gw; m < M; m += ngw) {
#pragma unroll
        for (int it = 0; it < 2; ++it) {
            const int c = lane + 64 * it;
            u32x4* p = (u32x4*)(O + (size_t)m * DM) + c;
            if (c >= 120) { *p = (u32x4){0u, 0u, 0u, 0u}; continue; }
            const int head = c >> 3, hg = head % 5, g = head / 5;
            const float l0 = lse[(size_t)hg * M + m], l1 = lse[(size_t)(5 + hg) * M + m], l2 = lse[(size_t)(10 + hg) * M + m];
            const float mx = fmaxf(l0, fmaxf(l1, l2)), e0 = __expf(l0 - mx), e1 = __expf(l1 - mx), e2 = __expf(l2 - mx);
            const float a = (g == 0 ? e0 : (g == 1 ? e1 : e2)) / (e0 + e1 + e2);
            u32x4 w = *p;
            w.x = pk2(__uint_as_float(w.x << 16) * a, __uint_as_float(w.x & 0xffff0000u) * a); w.y = pk2(__uint_as_float(w.y << 16) * a, __uint_as_float(w.y & 0xffff0000u) * a);
            w.z = pk2(__uint_as_float(w.z << 16) * a, __uint_as_float(w.z & 0xffff0000u) * a); w.w = pk2(__uint_as_float(w.w << 16) * a, __uint_as_float(w.w & 0xffff0000u) * a);
            *p = w;
        }
    }
}
__device__ __forceinline__ void mla_norm_pass(const float* Z, const float* qg, const float* kvg, const float* tabl, bf16* CQN, bf16* CKVN, bf16* Kb, int lane, int gw, int ngw) {
    for (int m = gw; m < M; m += ngw) {
        const float* z = Z + (size_t)m * 512;
        const f32x4 a = *((const f32x4*)z + lane); const f32x2_t c = *((const f32x2_t*)(z + 256) + lane);
        const float rq = rsqrtf(wave_sum((a.x * a.x + a.y * a.y) + (a.z * a.z + a.w * a.w)) * (1.f / 256.f) + RMS_EPS);
        const float rk = rsqrtf(wave_sum(c.x * c.x + c.y * c.y) * (1.f / 128.f) + RMS_EPS);
        const f32x4 g4 = *((const f32x4*)qg + lane); const f32x2_t g2 = *((const f32x2_t*)kvg + lane);
        *((u32x2*)(CQN + (size_t)m * 256) + lane) = (u32x2){pk2(a.x * rq * g4.x, a.y * rq * g4.y), pk2(a.z * rq * g4.z, a.w * rq * g4.w)};
        *((unsigned*)(CKVN + (size_t)m * 128) + lane) = pk2(c.x * rk * g2.x, c.y * rk * g2.y);
        const int b = m >> 11, s = m & 2047; const int j = lane & 15;
        const float x1 = z[384 + j], x2 = z[400 + j], cs = tabl[s * 32 + j], sn = tabl[s * 32 + 16 + j];
        const float o1 = x1 * cs - x2 * sn, o2 = x2 * cs + x1 * sn;
        const int head = lane >> 2, j0 = (lane & 3) * 4;
        float r1[4], r2[4];
#pragma unroll
        for (int q = 0; q < 4; ++q) { r1[q] = shfl_idx(o1, j0 + q); r2[q] = shfl_idx(o2, j0 + q); }
        bf16* kr = Kb + ((size_t)(b * 16 + head) * SEQ + s) * 96 + 64;
        *(u32x2*)(kr + j0) = (u32x2){pk2(r1[0], r1[1]), pk2(r1[2], r1[3])};
        *(u32x2*)(kr + 16 + j0) = (u32x2){pk2(r2[0], r2[1]), pk2(r2[2], r2[3])};
    }
}

__device__ __forceinline__ void xb_rowss_pass(const float* Xs, bf16* XBo, float* RS, int lane, int gw, int ngw) {
    for (int m = gw; m < M; m += ngw) {
        const f32x4* xr = (const f32x4*)(Xs + (size_t)m * DM) + lane; f32x4 v[4]; float s = 0.f;
#pragma unroll
        for (int j = 0; j < 4; ++j) { v[j] = xr[64 * j]; s += (v[j].x * v[j].x + v[j].y * v[j].y) + (v[j].z * v[j].z + v[j].w * v[j].w); }
        s = wave_sum(s);
        unsigned long long* o8 = (unsigned long long*)(XBo + (size_t)m * DM) + lane;
#pragma unroll
        for (int j = 0; j < 4; ++j) o8[64 * j] = (unsigned long long)pk2(v[j].x, v[j].y) | ((unsigned long long)pk2(v[j].z, v[j].w) << 32);
        if (lane < 16) RS[(size_t)m * 16 + lane] = (lane == 0) ? s : 0.f;
    }
}
__device__ __forceinline__ void final_norm_rs_pass(const bf16* XBs, float* Out, const float* g, const float* RS, int lane, int gw, int ngw) {
    for (int m = gw; m < M; m += ngw) {
        const u32x2* xr = (const u32x2*)(XBs + (size_t)m * DM) + lane; f32x4* orow = (f32x4*)(Out + (size_t)m * DM) + lane; const f32x4* gr = (const f32x4*)g + lane;
        const float rstd = rsqrtf(rowsum16(RS + (size_t)m * 16) * (1.f / DM) + RMS_EPS);
#pragma unroll
        for (int j = 0; j < 4; ++j) { const u32x2 w = xr[64 * j]; const f32x4 gg = gr[64 * j];
            orow[64 * j] = (f32x4){__uint_as_float(w.x << 16) * rstd * gg.x, __uint_as_float(w.x & 0xffff0000u) * rstd * gg.y, __uint_as_float(w.y << 16) * rstd * gg.z, __uint_as_float(w.y & 0xffff0000u) * rstd * gg.w}; }
    }
}

struct TrState { float wv[32]; f32x4 g0, g1; bf16* dst; int ldt; };
struct TrJob { int idx; unsigned src_off; int ldw, col0, ncols, K; unsigned dst_off; int ldt, row0, gidx, goff, item0; };
constexpr int N_TRJOBS = 60;
constexpr int N_TR_ITEMS = 26000;
__constant__ TrJob tr_jobs[N_TRJOBS + 1] = {
    {3, 0u, 2880, 0, 1920, 1024, 4194304u, 1024, 0, 2, 0, 0},
    {3, 0u, 2880, 1920, 960, 1024, 8388608u, 1024, 0, 2, 0, 960},
    {4, 0u, 1024, 0, 1024, 960, 10485760u, 1024, 0, -1, 0, 1440},
    {6, 0u, 416, 0, 416, 1024, 12582912u, 1024, 0, 5, 0, 1920},
    {8, 0u, 1536, 0, 1536, 256, 13631488u, 256, 0, -1, 0, 2128},
    {10, 0u, 2048, 0, 64, 128, 14417920u, 128, 0, -1, 0, 2320},
    {10, 0u, 2048, 64, 64, 128, 14680064u, 128, 0, -1, 0, 2324},
    {10, 0u, 2048, 128, 64, 128, 14417920u, 128, 64, -1, 0, 2328},
    {10, 0u, 2048, 192, 64, 128, 14680064u, 128, 64, -1, 0, 2332},
    {10, 0u, 2048, 256, 64, 128, 14417920u, 128, 128, -1, 0, 2336},
    {10, 0u, 2048, 320, 64, 128, 14680064u, 128, 128, -1, 0, 2340},
    {10, 0u, 2048, 384, 64, 128, 14417920u, 128, 192, -1, 0, 2344},
    {10, 0u, 2048, 448, 64, 128, 14680064u, 128, 192, -1, 0, 2348},
    {10, 0u, 2048, 512, 64, 128, 14417920u, 128, 256, -1, 0, 2352},
    {10, 0u, 2048, 576, 64, 128, 14680064u, 128, 256, -1, 0, 2356},
    {10, 0u, 2048, 640, 64, 128, 14417920u, 128, 320, -1, 0, 2360},
    {10, 0u, 2048, 704, 64, 128, 14680064u, 128, 320, -1, 0, 2364},
    {10, 0u, 2048, 768, 64, 128, 14417920u, 128, 384, -1, 0, 2368},
    {10, 0u, 2048, 832, 64, 128, 14680064u, 128, 384, -1, 0, 2372},
    {10, 0u, 2048, 896, 64, 128, 14417920u, 128, 448, -1, 0, 2376},
    {10, 0u, 2048, 960, 64, 128, 14680064u, 128, 448, -1, 0, 2380},
    {10, 0u, 2048, 1024, 64, 128, 14417920u, 128, 512, -1, 0, 2384},
    {10, 0u, 2048, 1088, 64, 128, 14680064u, 128, 512, -1, 0, 2388},
    {10, 0u, 2048, 1152, 64, 128, 14417920u, 128, 576, -1, 0, 2392},
    {10, 0u, 2048, 1216, 64, 128, 14680064u, 128, 576, -1, 0, 2396},
    {10, 0u, 2048, 1280, 64, 128, 14417920u, 128, 640, -1, 0, 2400},
    {10, 0u, 2048, 1344, 64, 128, 14680064u, 128, 640, -1, 0, 2404},
    {10, 0u, 2048, 1408, 64, 128, 14417920u, 128, 704, -1, 0, 2408},
    {10, 0u, 2048, 1472, 64, 128, 14680064u, 128, 704, -1, 0, 2412},
    {10, 0u, 2048, 1536, 64, 128, 14417920u, 128, 768, -1, 0, 2416},
    {10, 0u, 2048, 1600, 64, 128, 14680064u, 128, 768, -1, 0, 2420},
    {10, 0u, 2048, 1664, 64, 128, 14417920u, 128, 832, -1, 0, 2424},
    {10, 0u, 2048, 1728, 64, 128, 14680064u, 128, 832, -1, 0, 2428},
    {10, 0u, 2048, 1792, 64, 128, 14417920u, 128, 896, -1, 0, 2432},
    {10, 0u, 2048, 1856, 64, 128, 14680064u, 128, 896, -1, 0, 2436},
    {10, 0u, 2048, 1920, 64, 128, 14417920u, 128, 960, -1, 0, 2440},
    {10, 0u, 2048, 1984, 64, 128, 14680064u, 128, 960, -1, 0, 2444},
    {11, 0u, 1024, 0, 1024, 1024, 14942208u, 1024, 0, -1, 0, 2448},
    {13, 0u, 3072, 0, 2048, 1024, 17039360u, 1024, 0, 12, 0, 2960},
    {13, 0u, 3072, 2048, 1024, 1024, 21233664u, 1024, 0, 12, 0, 3984},
    {15, 0u, 1024, 0, 1024, 1024, 23330816u, 1024, 0, -1, 0, 4496},
    {17, 0u, 3072, 0, 2048, 1024, 25427968u, 1024, 0, 16, 0, 5008},
    {17, 0u, 3072, 2048, 1024, 1024, 29622272u, 1024, 0, 16, 0, 6032},
    {23, 0u, 1024, 0, 1024, 1024, 31719424u, 1024, 0, -1, 0, 6544},
    {25, 0u, 4096, 0, 4096, 1024, 33816576u, 1024, 0, 24, 0, 7056},
    {26, 0u, 1024, 0, 1024, 4096, 42205184u, 4096, 0, -1, 0, 9104},
    {28, 0u, 1024, 0, 1024, 1024, 50593792u, 1024, 0, 27, 0, 11152},
    {29, 0u, 1024, 0, 1024, 256, 52690944u, 256, 0, -1, 0, 11664},
    {25, 4194304u, 4096, 0, 4096, 1024, 53215232u, 1024, 0, 24, 1024, 11792},
    {26, 4194304u, 1024, 0, 1024, 4096, 61603840u, 4096, 0, -1, 0, 13840},
    {28, 1048576u, 1024, 0, 1024, 1024, 69992448u, 1024, 0, 27, 1024, 15888},
    {29, 262144u, 1024, 0, 1024, 256, 72089600u, 256, 0, -1, 0, 16400},
    {25, 8388608u, 4096, 0, 4096, 1024, 72613888u, 1024, 0, 24, 2048, 16528},
    {26, 8388608u, 1024, 0, 1024, 4096, 81002496u, 4096, 0, -1, 0, 18576},
    {28, 2097152u, 1024, 0, 1024, 1024, 89391104u, 1024, 0, 27, 2048, 20624},
    {29, 524288u, 1024, 0, 1024, 256, 91488256u, 256, 0, -1, 0, 21136},
    {25, 12582912u, 4096, 0, 4096, 1024, 92012544u, 1024, 0, 24, 3072, 21264},
    {26, 12582912u, 1024, 0, 1024, 4096, 100401152u, 4096, 0, -1, 0, 23312},
    {28, 3145728u, 1024, 0, 1024, 1024, 108789760u, 1024, 0, 27, 3072, 25360},
    {29, 786432u, 1024, 0, 1024, 256, 110886912u, 256, 0, -1, 0, 25872},
    {0, 0u, 0, 0, 32, 64, 0u, 0, 0, -1, 0, 26000},
};

#ifndef REP_ATTN_A
#define REP_ATTN_A 1
#endif
#ifndef REP_ATTN_B
#define REP_ATTN_B 1
#endif
#ifndef REP_ATTN_C
#define REP_ATTN_C 1
#endif
#ifndef REP_ATTN_D
#define REP_ATTN_D 1
#endif
#ifndef REP_P0
#define REP_P0 1
#endif
#ifndef REP_QKV
#define REP_QKV 1
#endif
#ifndef REP_UP
#define REP_UP 1
#endif
#ifndef REP_SYNC
#define REP_SYNC 1
#endif
struct Args { const float* in[31]; float* out; unsigned char* ws; int ph_lo, ph_hi; };
#define CAS __attribute__((address_space(4)))
__device__ __forceinline__ const float* in_ptr(int idx) {
    const CAS char* ka = (const CAS char*)__builtin_amdgcn_kernarg_segment_ptr(); asm volatile("" : "+s"(ka));
    return (const float*)*(const __attribute__((address_space(1))) float* const CAS*)(ka + idx * 8);
}

__global__ void __launch_bounds__(NTHREADS, 2) fwd_kernel(Args args) {
    extern __shared__ __attribute__((aligned(16))) unsigned char lds_raw[];
    LAS unsigned char* lds = (LAS unsigned char*)lds_raw;
    cg::grid_group grid = cg::this_grid();
#define XOUT ((float*)(__attribute__((address_space(1))) float*)args.out)
#define XD ((bf16*)(__attribute__((address_space(1))) bf16*)args.out)
#define HN ((bf16*)(ws + WS_HN))
#define PB ((bf16*)(ws + WS_PB))
#define Qb ((bf16*)(ws + WS_BIG + BIG_Q))
#define Kb ((bf16*)(ws + WS_BIG + BIG_K))
#define Vb ((bf16*)(ws + WS_BIG + BIG_V))
#define Ob ((bf16*)(ws + WS_BIG + BIG_O))
#define Hb ((bf16*)(ws + WS_BIG))
#define Tb ((bf16*)(ws + WS_BIG + BIG_O))
#define XBM ((bf16*)(ws + WS_BIG + BIG_O))
#define RS(i) ((float*)(ws + WS_RS) + (size_t)((i) % 3) * M * 16)
#define Zb ((float*)(ws + WS_HN))
#define CQN ((bf16*)(ws + WS_BIG + BIG_O))
#define CKVN ((bf16*)(ws + WS_BIG + BIG_O + 8 * MiB))
#define tabp ((float*)(ws + WS_TABP))
#define tabl ((float*)(ws + WS_TABL))
#define lse ((float*)(ws + WS_LSE))
    const int wave_s = __builtin_amdgcn_readfirstlane(threadIdx.x >> 6);
    volatile LAS unsigned* xb_st = (volatile LAS unsigned*)(lds + 131072 + 64);
    if (threadIdx.x == 0) { xb_st[0] = 0u; xb_st[1] = 0u; }
    __syncthreads();
    XcdBarrier xb = xcd_barrier_post((unsigned*)args.ws, xb_st, threadIdx.x == 0);
    if (args.ph_lo < 0) grid.sync();
    int ph = 0;
#define run_gemm(MODE, ...) run_gemm_<MODE>(__VA_ARGS__, wave_s)
#define attn_phase(MODE, ...) attn_phase_<MODE>(__VA_ARGS__, wave_s * 64 + lane_id_here())
#define PHASE_BEGIN if (ph >= args.ph_lo && ph < args.ph_hi) { __attribute__((address_space(1))) unsigned char* wsg_ = (__attribute__((address_space(1))) unsigned char*)args.ws; int bx_ = blockIdx.x, gx_ = gridDim.x; asm volatile("" : "+s"(wsg_), "+s"(bx_), "+s"(gx_)); unsigned char* ws = (unsigned char*)wsg_; \
    const int lane = lane_id_here(), wave = wave_s, tid = wave * 64 + lane, gw = bx_ * NWAVES + wave, ngw = gx_ * NWAVES; \
    LAS float* scr = (LAS float*)(lds + wave * 16384); (void)scr; (void)lane; (void)gw; (void)ngw;
#define PHASE_BEGIN_R(n) PHASE_BEGIN for (int rp_ = 0; rp_ < (n); ++rp_) {
#define PHASE_END_R } PHASE_END
#define PHASE_END   if (ph + 1 < args.ph_hi) { for (int rs_ = 0; rs_ < REP_SYNC; ++rs_) { xcd_barrier(xb, wave_s == 0 && lane_id_here() == 0); } } } ++ph;
#define WB(off) ((bf16*)(ws + (off)))
#define TR(idx, ldw, col0, ncols, K, dst, ldt, row0) tr_job(in_ptr(idx), ldw, col0, ncols, K, WB(dst), ldt, row0, scr, lane, gw, ngw)

    PHASE_BEGIN_R(REP_P0)
        {
            int jcur = 0;
#define TR_LOAD(S_, it_) do { while (tr_jobs[jcur + 1].item0 <= (it_)) ++jcur; const TrJob jb = tr_jobs[jcur]; \
                const int loc = (it_) - jb.item0, nblk = jb.ncols >> 5, kb = loc / nblk, nb = loc - kb * nblk, k0 = 64 * kb, n0 = 32 * nb; \
                const float* wp = in_ptr(jb.idx) + jb.src_off + (size_t)(k0 + (lane >> 5)) * jb.ldw + jb.col0 + n0 + (lane & 31); \
                _Pragma("unroll") for (int i = 0; i < 32; ++i) S_.wv[i] = wp[(size_t)(2 * i) * jb.ldw]; \
                S_.g0 = (f32x4){1.f, 1.f, 1.f, 1.f}; S_.g1 = S_.g0; \
                if (jb.gidx >= 0) { const float* gp = in_ptr(jb.gidx) + jb.goff + k0 + 8 * (lane & 7); S_.g0 = *(const f32x4*)gp; S_.g1 = *(const f32x4*)(gp + 4); } \
                S_.dst = (bf16*)(ws + jb.dst_off) + (size_t)(jb.row0 + n0) * jb.ldt + k0 + 8 * (lane & 7); S_.ldt = jb.ldt; } while (0)
#define TR_FINISH(S_) do { _Pragma("unroll") for (int i = 0; i < 32; ++i) scr[(2 * i + (lane >> 5)) * 33 + (lane & 31)] = S_.wv[i]; \
                asm volatile("s_waitcnt lgkmcnt(0)" ::: "memory"); \
                _Pragma("unroll") for (int j = 0; j < 4; ++j) { const int n = (lane >> 3) + 8 * j; const LAS float* sp = scr + (8 * (lane & 7)) * 33 + n; \
                    u32x4 o; o.x = pk2(sp[0 * 33] * S_.g0[0], sp[1 * 33] * S_.g0[1]); o.y = pk2(sp[2 * 33] * S_.g0[2], sp[3 * 33] * S_.g0[3]); \
                    o.z = pk2(sp[4 * 33] * S_.g1[0], sp[5 * 33] * S_.g1[1]); o.w = pk2(sp[6 * 33] * S_.g1[2], sp[7 * 33] * S_.g1[3]); \
                    *(u32x4*)(S_.dst + (size_t)n * S_.ldt) = o; } \
                asm volatile("s_waitcnt lgkmcnt(0)" ::: "memory"); } while (0)
            TrState A, B;
            int it = gw;
            if (it < N_TR_ITEMS) TR_LOAD(A, it);
            while (it < N_TR_ITEMS) {
                int nxt = it + ngw; if (nxt < N_TR_ITEMS) TR_LOAD(B, nxt);
                TR_FINISH(A);
                it = nxt; if (it >= N_TR_ITEMS) break;
                nxt = it + ngw; if (nxt < N_TR_ITEMS) TR_LOAD(A, nxt);
                TR_FINISH(B);
                it = nxt;
            }
#undef TR_LOAD
#undef TR_FINISH
        }
        for (int i = bx_ * NTHREADS + tid; i < 1024 * 8; i += gx_ * NTHREADS) *((u32x4*)(WB(W_A_O) + (size_t)(i >> 3) * 1024 + 960) + (i & 7)) = (u32x4){0u, 0u, 0u, 0u};
        for (int i = bx_ * NTHREADS + tid; i < SEQ * 24; i += gx_ * NTHREADS) {
            const int s = i / 24, r = i - s * 24;
            const bool isl = r >= 8; const int j = isl ? r - 8 : r; const float rot = isl ? 32.f : 16.f;
            const float inv = exp2f(-(2.f * (float)j / rot) * 18.931568569324174f);
            double rev = (double)s * (double)inv * 0.15915494309189535; rev -= floor(rev);
            const float cs = __builtin_amdgcn_cosf((float)rev), sn = __builtin_amdgcn_sinf((float)rev);
            if (isl) { tabl[s * 32 + j] = cs; tabl[s * 32 + 16 + j] = sn; } else { tabp[s * 16 + j] = cs; tabp[s * 16 + 8 + j] = sn; }
        }
        xb_rowss_pass(in_ptr(0), XBM, RS(0), lane, gw, ngw);
    PHASE_END_R

#pragma unroll
    for (int layer = 0; layer < 4; ++layer) {
        if (layer == 0) {
            PHASE_BEGIN_R(REP_QKV)
                { EpiP e{Qb, Kb, nullptr, tabp, 0, 960, 960, 15, 64, 1, 1, 64, RS(0), nullptr, nullptr, LOG2E * 0.125f}; run_gemm(EPI_QK, lds, XBM, WB(W_A_QK), M, 2048, DM, e); }
                { EpiP e{Vb, nullptr, nullptr, nullptr, 0, 960, 0, 15, 0, 0, 1, 64, RS(0), nullptr, nullptr}; run_gemm(EPI_VT, lds, WB(W_A_V), XBM, 1024, M, DM, e); }
            PHASE_END_R
            PHASE_BEGIN
                { AttnP a{Qb, Kb, Vb, Ob, lse, nullptr, nullptr, nullptr, nullptr, nullptr, nullptr, nullptr, 0.f, 0}; for (int rep_ = 0; rep_ < REP_ATTN_A; ++rep_) attn_phase(0, lds, a); }
            PHASE_END
            PHASE_BEGIN
                mix_pass(Ob, lse, lane, gw, ngw);
            PHASE_END
            PHASE_BEGIN
                { EpiP e{nullptr, nullptr, in_ptr(0), nullptr, DM, 0, 0, 0, 0, 1, 0, 0, nullptr, RS(1), HN}; run_gemm(EPI_RESID, lds, Ob, WB(W_A_O), M, DM, DM, e); }
                pconv_pass(in_ptr(1), PB, lane, gw, ngw);
            PHASE_END
        } else if (layer == 1) {
            PHASE_BEGIN
                { EpiP e{Zb, nullptr, nullptr, nullptr, 512, 0, 0, 0, 0, 0, 0, 0, RS(3), nullptr, nullptr}; run_gemm(EPI_F32, lds, XD, WB(W_B_IN), M, 512, DM, e); }
            PHASE_END
            PHASE_BEGIN
                mla_norm_pass(Zb, in_ptr(7), in_ptr(9), tabl, CQN, CKVN, Kb, lane, gw, ngw);
            PHASE_END
            PHASE_BEGIN
                { EpiP e{Qb, nullptr, nullptr, tabl, 0, 0, 0, 16, 96, 1, 0, 0, nullptr, nullptr, nullptr, LOG2E * 0.10206207261596575f}; run_gemm(EPI_MLAQ, lds, CQN, WB(W_B_UQ), M, 1536, 256, e); }
                { EpiP e{nullptr, Kb, nullptr, nullptr, 0, 0, 1024, 16, 96, 0, 0, 0, nullptr, nullptr, nullptr}; run_gemm(EPI_QK, lds, CKVN, WB(W_B_K), M, 1024, 128, e); }
                { EpiP e{Vb, nullptr, nullptr, nullptr, 0, 1024, 0, 16, 0, 0, 0, 64, nullptr, nullptr, nullptr}; run_gemm(EPI_VT, lds, WB(W_B_V), CKVN, 1024, M, 128, e); }
            PHASE_END
            PHASE_BEGIN
                { AttnP a{Qb, Kb, Vb, Ob, nullptr, nullptr, nullptr, nullptr, nullptr, nullptr, nullptr, nullptr, 0.f, 0}; for (int rep_ = 0; rep_ < REP_ATTN_B; ++rep_) attn_phase(1, lds, a); }
            PHASE_END
            PHASE_BEGIN
                { EpiP e{nullptr, nullptr, XD, nullptr, DM, 0, 0, 0, 0, 0, 0, 0, nullptr, RS(4), HN}; run_gemm(EPI_RESID, lds, Ob, WB(W_B_O), M, DM, DM, e); }
                pconv_pass(in_ptr(1) + (size_t)1 * M * 256, PB, lane, gw, ngw);
            PHASE_END
        } else if (layer == 2) {
            PHASE_BEGIN_R(REP_QKV)
                { EpiP e{Qb, Kb, nullptr, nullptr, 0, 1024, 1024, 16, 64, 0, 0, 64, RS(6), nullptr, nullptr, LOG2E * 0.125f}; run_gemm(EPI_QK, lds, XD, WB(W_C_QK), M, 2048, DM, e); }
                { EpiP e{Vb, nullptr, nullptr, nullptr, 0, 1024, 0, 16, 0, 0, 0, 64, RS(6), nullptr, nullptr}; run_gemm(EPI_VT, lds, WB(W_C_V), XD, 1024, M, DM, e); }
            PHASE_END_R
            PHASE_BEGIN
                { AttnP a{Qb, Kb, Vb, Ob, nullptr, in_ptr(14), nullptr, nullptr, nullptr, nullptr, nullptr, nullptr, 0.f, 0}; for (int rep_ = 0; rep_ < REP_ATTN_C; ++rep_) attn_phase(2, lds, a); }
            PHASE_END
            PHASE_BEGIN
                { EpiP e{nullptr, nullptr, XD, nullptr, DM, 0, 0, 0, 0, 0, 0, 0, nullptr, RS(7), HN}; run_gemm(EPI_RESID, lds, Ob, WB(W_C_O), M, DM, DM, e); }
                pconv_pass(in_ptr(1) + (size_t)2 * M * 256, PB, lane, gw, ngw);
            PHASE_END
        } else {
            PHASE_BEGIN_R(REP_QKV)
                { EpiP e{Qb, Kb, nullptr, tabp, 0, 1024, 1024, 16, 64, 1, 0, 64, RS(9), nullptr, nullptr, LOG2E * 0.125f}; run_gemm(EPI_QK, lds, XD, WB(W_D_QK), M, 2048, DM, e); }
                { EpiP e{Vb, nullptr, nullptr, nullptr, 0, 1024, 0, 8, 0, 0, 0, 128, RS(9), nullptr, nullptr}; run_gemm(EPI_VT, lds, WB(W_D_V), XD, 1024, M, DM, e); }
            PHASE_END_R
            PHASE_BEGIN
                { const float li = 0.8f - 0.6f * 0.40656965974059917f;
                  AttnP a{Qb, Kb, Vb, Ob, nullptr, nullptr, in_ptr(18), in_ptr(19), in_ptr(20), in_ptr(21), in_ptr(22), (float*)HN, li, 0}; for (int rep_ = 0; rep_ < REP_ATTN_D; ++rep_) attn_phase(3, lds, a); }
            PHASE_END
            PHASE_BEGIN
                { EpiP e{nullptr, nullptr, XD, nullptr, DM, 0, 0, 0, 0, 0, 0, 0, nullptr, RS(10), HN}; run_gemm(EPI_RESID, lds, Ob, WB(W_D_O), M, DM, DM, e); }
                pconv_pass(in_ptr(1) + (size_t)3 * M * 256, PB, lane, gw, ngw);
            PHASE_END
        }
        const size_t wl = W_L + (size_t)layer * W_L_STRIDE;
        PHASE_BEGIN_R(REP_UP)
            { EpiP e{Hb, nullptr, nullptr, nullptr, FF, 0, 0, 0, 0, 0, 0, 0, RS(3 * layer + 1), nullptr, nullptr}; run_gemm(EPI_SQRELU, lds, HN, WB(wl + W_L_UP), M, FF, DM, e); }
            { EpiP e{Tb, nullptr, nullptr, nullptr, DM, 0, 0, 0, 0, 0, 0, 0, nullptr, nullptr, nullptr}; run_gemm(EPI_BF16, lds, PB, WB(wl + W_L_PROJ), M, DM, 256, e); }
        PHASE_END_R
        PHASE_BEGIN
            { EpiP e{nullptr, nullptr, HN, nullptr, DM, 0, 0, 0, 0, 0, 0, 0, nullptr, RS(3 * layer + 2), HN}; run_gemm(EPI_RESID, lds, Hb, WB(wl + W_L_DOWN), M, DM, FF, e); }
        PHASE_END
        PHASE_BEGIN
            { EpiP e{nullptr, HN, Tb, nullptr, DM, 0, 0, 0, 0, 0, 0, 0, RS(3 * layer + 2), RS(3 * layer + 3), (layer < 3) ? XD : XBM}; run_gemm(EPI_GATE, lds, HN, WB(wl + W_L_GATE), M, DM, DM, e); }
        PHASE_END
    }
    PHASE_BEGIN
        final_norm_rs_pass(XBM, XOUT, in_ptr(30), RS(12), lane, gw, ngw);
    PHASE_END
}
constexpr int N_PHASES = 1 + 4 + 5 + 3 + 3 + 4 * 3 + 1;

#ifndef MULTI_LAUNCH
#define MULTI_LAUNCH 0
#endif
extern "C" void kernel_launch(void* const* d_in, const int* in_sizes, int n_in, void* d_out, int out_size, void* d_ws, size_t ws_size, hipStream_t stream) {
    static int grid = 0;
    if (grid == 0) {
        if (n_in != 31 || ws_size < WS_END) { fprintf(stderr, "kernel_launch: unexpected inputs (n_in %d, ws %zu, need %zu)\n", n_in, ws_size, (size_t)WS_END); grid = -1; return; }
        int dev = 0, cus = 0, per_cu = 0;
        hipGetDevice(&dev); hipDeviceGetAttribute(&cus, hipDeviceAttributeMultiprocessorCount, dev);
        if (hipFuncSetAttribute((const void*)fwd_kernel, hipFuncAttributeMaxDynamicSharedMemorySize, LDS_BYTES) != hipSuccess) { fprintf(stderr, "kernel_launch: hipFuncSetAttribute failed\n"); grid = -1; return; }
        hipOccupancyMaxActiveBlocksPerMultiprocessor(&per_cu, (const void*)fwd_kernel, NTHREADS, LDS_BYTES);
        (void)hipGetLastError();
        if (per_cu < 1) per_cu = 1;
        grid = cus * 1;
        fprintf(stderr, "kernel_launch: cus %d per_cu %d grid %d\n", cus, per_cu, grid);
    }
    if (grid < 0) return;
    if (hipMemsetAsync(d_ws, 0, 16384, stream) != hipSuccess) { fprintf(stderr, "kernel_launch: memset of the barrier words failed\n"); return; }
    Args a{};
    for (int i = 0; i < 31; ++i) a.in[i] = (const float*)d_in[i];
    a.out = (float*)d_out; a.ws = (unsigned char*)d_ws;
#if MULTI_LAUNCH
    for (int p = 0; p < N_PHASES; ++p) { a.ph_lo = p; a.ph_hi = p + 1; hipLaunchKernelGGL(fwd_kernel, dim3(grid), dim3(NTHREADS), LDS_BYTES, stream, a); }
#else
    a.ph_lo = 0; a.ph_hi = N_PHASES;
    void* kargs[] = {&a};
    hipError_t e = hipLaunchCooperativeKernel((const void*)fwd_kernel, dim3(grid), dim3(NTHREADS), kargs, LDS_BYTES, stream);
    if (e != hipSuccess) fprintf(stderr, "cooperative launch failed: %s (grid %d)\n", hipGetErrorString(e), grid);
#endif
}
```
